# Optimizing an MI355X kernel written in HIP

```python
import math
import jax, jax.numpy as jnp
from jax import lax
import numpy as np

D_MODEL = 2048
BATCH = 8
SEQ = 2048
DEPTH = 4

GRID_W = 64
MIX_WIDTH = D_MODEL
HALF = MIX_WIDTH // 2
HEAD_DIM = 128
NA_HEADS = HALF // HEAD_DIM
NA_WIN_ROWS_MAX = 8
NA_WIN_COLS = 16
HG_HEADS = HALF // HEAD_DIM
HG_EXPAND = 128
HG_FDIM = HG_HEADS * HG_EXPAND
HG_VDIM = HALF // HG_HEADS
HG_CHUNK = 64
POOL_WINDOWS = (2, 4, 8, 16)
POOL_GROUPS = len(POOL_WINDOWS)
POOL_GROUP_DIM = HALF // POOL_GROUPS
GQA_Q_HEADS = HALF // HEAD_DIM
GQA_KV_HEADS = 2
KV_W = GQA_KV_HEADS * HEAD_DIM
Q_BLOCK = 128
ROPE_THETA = 10000.0
FFN_HIDDEN = -(-8 * D_MODEL // (3 * 256)) * 256
AB_IN = 3 * HALF + 2 * HG_FDIM + HG_FDIM + 2 * HALF
CD_IN = HALF + HALF + 2 * KV_W
N_AB = (DEPTH + 1) // 2
N_CD = DEPTH // 2
DN_ALPHA = (2 * DEPTH) ** 0.25
DN_BETA = (8 * DEPTH) ** -0.25
LN_EPS = 1e-5
RMS_EPS = 1e-6

kernel_name = "hybrid_natten_hgrn2_pool_gqa_encoder"


def layer_norm(x, g, b):
    xf = x.astype(jnp.float32)
    mu = jnp.mean(xf, axis=-1, keepdims=True)
    var = jnp.mean(jnp.square(xf - mu), axis=-1, keepdims=True)
    return ((xf - mu) * lax.rsqrt(var + LN_EPS)).astype(x.dtype) * g + b


def rms_norm(x, g):
    xf = x.astype(jnp.float32)
    ms = jnp.mean(jnp.square(xf), axis=-1, keepdims=True)
    return (xf * lax.rsqrt(ms + RMS_EPS)).astype(x.dtype) * g


def neighbourhood_attention(q, k, v, rpb):
    b, t, h, dh = q.shape
    rows = t // GRID_W
    kh = min(NA_WIN_ROWS_MAX, rows)
    qg = q.reshape(b, rows, GRID_W, h, dh) * (dh ** -0.5)
    kg = k.reshape(b, rows, GRID_W, h, dh)
    vg = v.reshape(b, rows, GRID_W, h, dh)
    col = jnp.arange(GRID_W)
    col_start = jnp.clip(col - NA_WIN_COLS // 2, 0, GRID_W - NA_WIN_COLS)
    col_mask = (col[None, :] >= col_start[:, None]) & (col[None, :] < col_start[:, None] + NA_WIN_COLS)
    col_idx = jnp.clip(col[None, :] - col[:, None] + NA_WIN_COLS - 1, 0, 2 * NA_WIN_COLS - 2)

    def row_step(r):
        r0 = jnp.clip(r - kh // 2, 0, rows - kh)
        k_band = lax.dynamic_slice_in_dim(kg, r0, kh, axis=1)
        v_band = lax.dynamic_slice_in_dim(vg, r0, kh, axis=1)
        q_row = lax.dynamic_index_in_dim(qg, r, axis=1, keepdims=False)
        s = jnp.einsum('bqhd,bjkhd->bhqjk', q_row, k_band).astype(jnp.float32)
        row_idx = r0 + jnp.arange(kh) - r + NA_WIN_ROWS_MAX - 1
        bias = rpb[:, row_idx[None, :, None], col_idx[:, None, :]]
        s = s + bias[None].astype(jnp.float32)
        s = jnp.where(col_mask[None, None, :, None, :], s, -jnp.inf)
        p = jax.nn.softmax(s.reshape(b, h, GRID_W, kh * GRID_W), axis=-1)
        p = p.astype(v.dtype).reshape(b, h, GRID_W, kh, GRID_W)
        return jnp.einsum('bhqjk,bjkhd->bqhd', p, v_band)

    out = lax.map(row_step, jnp.arange(rows))
    return out.transpose(1, 0, 2, 3, 4).reshape(b, t, h * dh)


def chunked_gated_recurrence(q, k, v, log_f):
    b, h, t, dk = q.shape
    dv = v.shape[-1]
    c = HG_CHUNK
    n = t // c

    def to_chunks(a):
        return a.astype(jnp.float32).reshape(b, h, n, c, a.shape[-1]).transpose(2, 0, 1, 3, 4)

    qc, kc, vc, gc = (to_chunks(a) for a in (q, k, v, log_f))
    lower = jnp.tril(jnp.ones((c, c), dtype=bool))

    def step(S, inp):
        qi, ki, vi, gi = inp
        G = jnp.cumsum(gi, axis=2)
        diff = G[:, :, :, None, :] - G[:, :, None, :, :]
        decay = jnp.exp(jnp.where(lower[None, None, :, :, None], diff, -jnp.inf))
        A = jnp.einsum('bhtd,bhtsd,bhsd->bhts', qi, decay, ki)
        o = jnp.einsum('bhts,bhsv->bhtv', A, vi) + jnp.einsum('bhtd,bhdv->bhtv', qi * jnp.exp(G), S)
        G_last = G[:, :, -1:, :]
        S = jnp.exp(G_last[:, :, 0, :])[..., None] * S + jnp.einsum('bhsd,bhsv->bhdv', ki * jnp.exp(G_last - G), vi)
        return S, o

    S0 = jnp.zeros((b, h, dk, dv), jnp.float32)
    _, o = lax.scan(step, S0, (qc, kc, vc, gc))
    return o.transpose(1, 2, 0, 3, 4).reshape(b, h, t, dv)


def hgrn2_mixer(q_in, ff_in, fb_in, i_in, g_in, lb, norm_w):
    b, t, _ = q_in.shape

    def heads(z, d):
        return z.reshape(b, t, HG_HEADS, d).transpose(0, 2, 1, 3)

    q = heads(jax.nn.silu(q_in), HG_EXPAND)
    v = heads(i_in, HG_VDIM)

    def direction(z, reverse):
        zf = z.astype(jnp.float32)
        f = lb + (1.0 - lb) * jax.nn.sigmoid(zf)
        k = (1.0 - lb) * jax.nn.sigmoid(-zf)
        args = (q, heads(k, HG_EXPAND), v, heads(jnp.log(f), HG_EXPAND))
        if reverse:
            args = tuple(jnp.flip(a, axis=2) for a in args)
            return jnp.flip(chunked_gated_recurrence(*args), axis=2)
        return chunked_gated_recurrence(*args)

    o = direction(ff_in, False) + direction(fb_in, True)
    o = rms_norm(o.transpose(0, 2, 1, 3), norm_w.reshape(HG_HEADS, HG_VDIM))
    return o.reshape(b, t, HALF).astype(g_in.dtype) * jax.nn.silu(g_in)


def multiscale_pool(x, w_groups, scale):
    b, t, _ = x.shape
    xf = x.astype(jnp.float32)
    cs = jnp.concatenate([jnp.zeros((b, 1, HALF), jnp.float32), jnp.cumsum(xf, axis=1)], axis=1)
    pos = jnp.arange(t)
    outs = []
    for gi, w in enumerate(POOL_WINDOWS):
        sl = slice(gi * POOL_GROUP_DIM, (gi + 1) * POOL_GROUP_DIM)
        lo = jnp.clip(pos - w // 2, 0, t)
        hi = jnp.clip(pos + w // 2, 0, t)
        seg = cs[:, :, sl]
        mean = (seg[:, hi] - seg[:, lo]) / (hi - lo).astype(jnp.float32)[None, :, None]
        outs.append(mean - xf[:, :, sl])
    pooled = jnp.stack(outs, axis=2).astype(x.dtype)
    y = jnp.einsum('btgc,gcd->btgd', pooled, w_groups).reshape(b, t, HALF)
    return y * scale


def axial_rope_tables(t):
    pos = jnp.arange(t)
    row = (pos // GRID_W).astype(jnp.float32)
    col = (pos % GRID_W).astype(jnp.float32)
    n_freq = HEAD_DIM // 4
    inv = ROPE_THETA ** (-jnp.arange(n_freq, dtype=jnp.float32) / n_freq)
    ang = jnp.concatenate([row[:, None] * inv, col[:, None] * inv], axis=-1)
    return jnp.cos(ang), jnp.sin(ang)


def apply_axial_rope(x, cos, sin):
    xr = x.astype(jnp.float32).reshape(*x.shape[:-1], HEAD_DIM // 2, 2)
    x0, x1 = xr[..., 0], xr[..., 1]
    c = cos[None, :, None, :]
    s = sin[None, :, None, :]
    out = jnp.stack([x0 * c - x1 * s, x0 * s + x1 * c], axis=-1).reshape(x.shape)
    return out.astype(x.dtype)


def gqa_attention(q, k, v):
    b, t, hq, dh = q.shape
    hkv = k.shape[2]
    g = hq // hkv
    qb = (q * (dh ** -0.5)).reshape(b, t // Q_BLOCK, Q_BLOCK, hkv, g, dh).transpose(1, 0, 2, 3, 4, 5)

    def block(qi):
        s = jnp.einsum('bqkgd,bskd->bkgqs', qi, k).astype(jnp.float32)
        p = jax.nn.softmax(s, axis=-1).astype(v.dtype)
        return jnp.einsum('bkgqs,bskd->bqkgd', p, v)

    o = lax.map(block, qb)
    return o.transpose(1, 0, 2, 3, 4, 5).reshape(b, t, hq * dh)


def ab_mixer(x, w_in, w_out, rpb, lb, hg_norm_w):
    b, t, _ = x.shape
    proj = x @ w_in
    a_q, a_k, a_v, h_q, h_ff, h_fb, h_i, h_g = jnp.split(proj, 8, axis=-1)

    def heads(z):
        return z.reshape(b, t, NA_HEADS, HEAD_DIM)

    y_a = neighbourhood_attention(heads(a_q), heads(a_k), heads(a_v), rpb)
    y_b = hgrn2_mixer(h_q, h_ff, h_fb, h_i, h_g, lb, hg_norm_w)
    return jnp.concatenate([y_a, y_b], axis=-1) @ w_out


def cd_mixer(x, w_in, w_out, pool_w, pool_scale, q_norm, k_norm, cos, sin):
    b, t, _ = x.shape
    proj = x @ w_in
    c_x, d_q, d_k, d_v = jnp.split(proj, [HALF, 2 * HALF, 2 * HALF + KV_W], axis=-1)
    y_c = multiscale_pool(c_x, pool_w, pool_scale)
    q = apply_axial_rope(rms_norm(d_q.reshape(b, t, GQA_Q_HEADS, HEAD_DIM), q_norm), cos, sin)
    k = apply_axial_rope(rms_norm(d_k.reshape(b, t, GQA_KV_HEADS, HEAD_DIM), k_norm), cos, sin)
    v = d_v.reshape(b, t, GQA_KV_HEADS, HEAD_DIM)
    y_d = gqa_attention(q, k, v)
    return jnp.concatenate([y_c, y_d], axis=-1) @ w_out


def swiglu(x, w_gate, w_up, w_down):
    return (jax.nn.silu(x @ w_gate) * (x @ w_up)) @ w_down


def setup_inputs(seed: int = 0) -> dict:
    key = jax.random.key(seed)
    ks = jax.random.split(key, 19)
    n = jax.random.normal
    f32 = jnp.float32
    return {
        "x": n(ks[0], (BATCH, SEQ, D_MODEL), f32),
        "ab_w_in": n(ks[1], (N_AB, D_MODEL, AB_IN), f32) * D_MODEL ** -0.5,
        "ab_w_out": n(ks[2], (N_AB, MIX_WIDTH, D_MODEL), f32) * (MIX_WIDTH ** -0.5 * DN_BETA),
        "na_rpb": 0.1 * n(ks[3], (N_AB, NA_HEADS, 2 * NA_WIN_ROWS_MAX - 1, 2 * NA_WIN_COLS - 1), f32),
        "hg_lb_logits": 0.5 * n(ks[4], (N_AB, HG_FDIM), f32),
        "hg_norm_w": 1.0 + 0.1 * n(ks[5], (N_AB, HALF), f32),
        "cd_w_in": n(ks[6], (N_CD, D_MODEL, CD_IN), f32) * D_MODEL ** -0.5,
        "cd_w_out": n(ks[7], (N_CD, MIX_WIDTH, D_MODEL), f32) * (MIX_WIDTH ** -0.5 * DN_BETA),
        "pool_w": n(ks[8], (N_CD, POOL_GROUPS, POOL_GROUP_DIM, POOL_GROUP_DIM), f32) * POOL_GROUP_DIM ** -0.5,
        "pool_scale": 1.0 + 0.1 * n(ks[9], (N_CD, HALF), f32),
        "d_q_norm": 1.0 + 0.1 * n(ks[10], (N_CD, HEAD_DIM), f32),
        "d_k_norm": 1.0 + 0.1 * n(ks[11], (N_CD, HEAD_DIM), f32),
        "ln_mix_g": 1.0 + 0.1 * n(ks[12], (DEPTH, D_MODEL), f32),
        "ln_mix_b": 0.02 * n(ks[13], (DEPTH, D_MODEL), f32),
        "ffn_w_gate": n(ks[14], (DEPTH, D_MODEL, FFN_HIDDEN), f32) * D_MODEL ** -0.5,
        "ffn_w_up": n(ks[15], (DEPTH, D_MODEL, FFN_HIDDEN), f32) * D_MODEL ** -0.5,
        "ffn_w_down": n(ks[16], (DEPTH, FFN_HIDDEN, D_MODEL), f32) * (FFN_HIDDEN ** -0.5 * DN_BETA),
        "ln_ffn_g": 1.0 + 0.1 * n(ks[17], (DEPTH, D_MODEL), f32),
        "ln_ffn_b": 0.02 * n(ks[18], (DEPTH, D_MODEL), f32),
    }


def reference(x, ab_w_in, ab_w_out, na_rpb, hg_lb_logits, hg_norm_w, cd_w_in, cd_w_out,
              pool_w, pool_scale, d_q_norm, d_k_norm, ln_mix_g, ln_mix_b,
              ffn_w_gate, ffn_w_up, ffn_w_down, ln_ffn_g, ln_ffn_b):
    t = x.shape[1]
    cos, sin = axial_rope_tables(t)
    lb_p = jax.nn.softmax(hg_lb_logits.astype(jnp.float32), axis=0)
    lower_bounds = jnp.cumsum(lb_p, axis=0) - lb_p[0]
    for layer in range(DEPTH):
        j = layer // 2
        if layer % 2 == 0:
            y = ab_mixer(x, ab_w_in[j], ab_w_out[j], na_rpb[j], lower_bounds[j], hg_norm_w[j])
        else:
            y = cd_mixer(x, cd_w_in[j], cd_w_out[j], pool_w[j], pool_scale[j],
                         d_q_norm[j], d_k_norm[j], cos, sin)
        x = layer_norm(DN_ALPHA * x + y, ln_mix_g[layer], ln_mix_b[layer])
        f = swiglu(x, ffn_w_gate[layer], ffn_w_up[layer], ffn_w_down[layer])
        x = layer_norm(DN_ALPHA * x + f, ln_ffn_g[layer], ln_ffn_b[layer])
    return x
```

```cpp
#include <hip/hip_runtime.h>
#include <hip/hip_bf16.h>
#include <hip/hip_cooperative_groups.h>
#include <cstdio>
#include <cstdint>
namespace cg = cooperative_groups;
__device__ __forceinline__ int ltid() { int t = __builtin_amdgcn_workitem_id_x(); asm volatile("" : "+v"(t)); return t; }
__device__ __forceinline__ int lbid() { int t = __builtin_amdgcn_workgroup_id_x(); asm volatile("" : "+s"(t)); return t; }
__device__ __forceinline__ int lgdim() { int t = (int)__ockl_get_num_groups(0); asm volatile("" : "+s"(t)); return t; }

#ifndef MK_SINGLE
#define MK_SINGLE 1
#endif

namespace pg8 {
#define PG8_LAS __attribute__((address_space(3)))
typedef unsigned short bf16_t;
typedef short bf16x8 __attribute__((ext_vector_type(8)));
typedef float f32x4 __attribute__((ext_vector_type(4)));
typedef unsigned u32x4 __attribute__((ext_vector_type(4)));
constexpr int BM = 256, BK = 64, HALF = 128, HTB = HALF * BK * 2  , STAGE_BYTES = 8 * HTB, NXCD = 8, WGM = 4;

__host__ __device__ __forceinline__ int lds_byte(int r, int c) { const int st = (r >> 4) * 2 + (c >> 5), rr = r & 15, cc = c & 31, ob = rr * 64 + cc * 2; return st * 1024 + (ob ^ (((ob >> 9) & 1) << 5)); }
__host__ __device__ __forceinline__ void stage_rc(int b, int& R, int& C) { const int st = b / 1024, sb = b % 1024, swz = sb ^ (((sb >> 9) & 1) << 5); R = (st >> 1) * 16 + swz / 64; C = (st & 1) * 32 + (swz % 64) / 2; }
__host__ __device__ __forceinline__ int perm32(int rho) { const int n = rho >> 4, i = rho & 15; return 8 * (i >> 2) + 4 * n + (i & 3); }

struct Unit { int pm, pn; };
struct Gemm { const bf16_t* A; const bf16_t* Bt; int M, N, K, lda; long apn; };

struct StaticOrder {
    int nM, nN, nwg, G, c;
    __host__ __device__ void init(int M, int N, int G_, int c_) { nM = M / BM; nN = N / BM; nwg = nM * nN; G = G_; c = c_; }
    __host__ __device__ bool next(int i, Unit& u) const {
        const long L = (long)i * G + c; if (L >= nwg) return false;
        int wgid = (int)L; { const int q = nwg / NXCD, r = nwg % NXCD, xcd = wgid % NXCD, off = wgid / NXCD; wgid = (xcd < r ? xcd * (q + 1) : r * (q + 1) + (xcd - r) * q) + off; }
        const int nig = WGM * nN, gid = wgid / nig, fm = gid * WGM, gsz = (nM - fm) < WGM ? (nM - fm) : WGM;
        u.pm = fm + ((wgid % nig) % gsz); u.pn = (wgid % nig) / gsz; return true;
    }
    __device__ __forceinline__ void a_ready(const Unit&) const {}
    __device__ __forceinline__ void done(const Unit&) const {}
};

__device__ __forceinline__ unsigned cvt_pk_bf16(float lo, float hi) { unsigned r; asm volatile("v_cvt_pk_bf16_f32 %0, %1, %2" : "=v"(r) : "v"(lo), "v"(hi)); return r; }
typedef float f32x2 __attribute__((ext_vector_type(2)));

struct EpiBf16S {
    static constexpr bool PERM = true, AFTER_DRAIN = false;
    bf16_t* O; int ldc; const float* cs; int a0, a1, a2;
    __device__ __forceinline__ void operator()(const f32x4 (&acc)[2][2][4][2], const Unit& u, int wr, int wc, int fr, int fq) const {
        const int row0 = u.pm * BM + wr * 64 + fr, col0 = u.pn * BM + wc * 32 + 8 * fq;
        const int act = (u.pn >= a0 && u.pn < a1) ? 1 : ((u.pn >= a1 && u.pn < a2) ? 2 : 0);
        f32x4 sv[2][2];
#pragma unroll
        for (int bj = 0; bj < 2; ++bj)
#pragma unroll
            for (int n = 0; n < 2; ++n) sv[bj][n] = cs ? *(const f32x4*)(cs + col0 + bj * HALF + 4 * n) : (f32x4){1.f, 1.f, 1.f, 1.f};
#pragma unroll
        for (int ai = 0; ai < 2; ++ai)
#pragma unroll
            for (int m = 0; m < 4; ++m) { bf16_t* rowp = O + (size_t)(row0 + ai * HALF + m * 16) * ldc + col0;
#pragma unroll
                for (int bj = 0; bj < 2; ++bj) { f32x4 v0 = acc[ai][bj][m][0] * sv[bj][0], v1 = acc[ai][bj][m][1] * sv[bj][1];
                    if (act) {
#pragma unroll
                        for (int e = 0; e < 4; ++e) { const float s0 = __builtin_amdgcn_rcpf(1.0f + __builtin_amdgcn_exp2f(-1.4426950408889634f * v0[e])), s1 = __builtin_amdgcn_rcpf(1.0f + __builtin_amdgcn_exp2f(-1.4426950408889634f * v1[e]));
                            v0[e] = (act == 1) ? v0[e] * s0 : s0; v1[e] = (act == 1) ? v1[e] * s1 : s1; } }
                    u32x4 w; w.x = cvt_pk_bf16(v0[0], v0[1]); w.y = cvt_pk_bf16(v0[2], v0[3]); w.z = cvt_pk_bf16(v1[0], v1[1]); w.w = cvt_pk_bf16(v1[2], v1[3]);
                    *(u32x4*)(rowp + bj * HALF) = w; } }
    }
};
struct EpiF32 {
    static constexpr bool PERM = false, AFTER_DRAIN = false;
    float* O; const float* R; int ldc; float alpha; const float* st; const float* g; const float* b;
    __device__ __forceinline__ void operator()(const f32x4 (&acc)[2][2][4][2], const Unit& u, int wr, int wc, int fr, int fq) const {
        const int row0 = u.pm * BM + wr * 64 + fr, col0 = u.pn * BM + wc * 32 + 4 * fq;
        f32x4 gv[2][2], bv[2][2];
#pragma unroll
        for (int bj = 0; bj < 2; ++bj)
#pragma unroll
            for (int n = 0; n < 2; ++n) { gv[bj][n] = st ? *(const f32x4*)(g + col0 + bj * HALF + n * 16) : (f32x4){1.f, 1.f, 1.f, 1.f}; bv[bj][n] = st ? *(const f32x4*)(b + col0 + bj * HALF + n * 16) : (f32x4){0.f, 0.f, 0.f, 0.f}; }
#pragma unroll
        for (int ai = 0; ai < 2; ++ai)
#pragma unroll
            for (int m = 0; m < 4; ++m) { const int row = row0 + ai * HALF + m * 16; float* rowp = O + (size_t)row * ldc + col0; const float* rsrc = R + (size_t)row * ldc + col0;
                float mean = 0.f, rstd = 1.f; if (st) { mean = st[2 * row]; rstd = st[2 * row + 1]; }
                f32x4 xr[2][2];
#pragma unroll
                for (int bj = 0; bj < 2; ++bj)
#pragma unroll
                    for (int n = 0; n < 2; ++n) xr[bj][n] = *(const f32x4*)(rsrc + bj * HALF + n * 16);
#pragma unroll
                for (int bj = 0; bj < 2; ++bj)
#pragma unroll
                    for (int n = 0; n < 2; ++n) { const f32x4 xn = (xr[bj][n] - mean) * rstd * gv[bj][n] + bv[bj][n]; *(f32x4*)(rowp + bj * HALF + n * 16) = acc[ai][bj][m][n] + xn * alpha; }
                asm volatile("" ::: "memory"); }
    }
};
struct EpiSwiGLU {
    static constexpr bool PERM = true, AFTER_DRAIN = false;
    bf16_t* Hh; int ldh;
    __device__ __forceinline__ void operator()(const f32x4 (&acc)[2][2][4][2], const Unit& u, int wr, int wc, int fr, int fq) const {
        const int row0 = u.pm * BM + wr * 64 + fr, col0 = u.pn * HALF + wc * 32 + 8 * fq;
#pragma unroll
        for (int ai = 0; ai < 2; ++ai)
#pragma unroll
            for (int m = 0; m < 4; ++m) { bf16_t* rowp = Hh + (size_t)(row0 + ai * HALF + m * 16) * ldh + col0;
                float h[8];
#pragma unroll
                for (int n = 0; n < 2; ++n)
#pragma unroll
                    for (int e = 0; e < 4; ++e) { const float g = acc[ai][0][m][n][e], up = acc[ai][1][m][n][e];
                        const float sg = __builtin_amdgcn_rcpf(1.0f + __builtin_amdgcn_exp2f(-1.4426950408889634f * g));
                        h[n * 4 + e] = g * sg * up; }
                u32x4 w; w.x = cvt_pk_bf16(h[0], h[1]); w.y = cvt_pk_bf16(h[2], h[3]); w.z = cvt_pk_bf16(h[4], h[5]); w.w = cvt_pk_bf16(h[6], h[7]);
                *(u32x4*)rowp = w; }
    }
};
template <class Epi, class Sched, bool ALIGN_EPI, bool SP2, int KC, int LDA, int APN>
__device__ __forceinline__ void gemm_phase(PG8_LAS unsigned char* lds, const Gemm g, const Sched& S, const Epi& E) {
    const int tid = ltid(), wid = __builtin_amdgcn_readfirstlane(tid >> 6), lane = tid & 63, wr = wid >> 2, wc = wid & 3, fr = lane & 15, fq = lane >> 4;
    constexpr int K = KC, nt = K / BK;
    unsigned voffA[2], voffB[2];
#pragma unroll
    for (int i = 0; i < 2; ++i) { int R, C; stage_rc(tid * 16 + i * 8192, R, C); const int Rb = Epi::PERM ? ((R & ~31) + perm32(R & 31)) : R;
        voffA[i] = (unsigned)(R * LDA + C) * 2u; voffB[i] = (unsigned)(Rb * K + C) * 2u; }
    const size_t kstep = (size_t)(BK * 2);
    const size_t hstepB = (size_t)HALF * K * 2, hstepA = (size_t)HALF * LDA * 2;
    const size_t tstepB = 2 * hstepB, tstepA = 2 * hstepA;
    const unsigned ldsw = (unsigned)wid * 1024u;
    const int aoff = lds_byte(wr * 64 + fr, fq * 8), boff = lds_byte(wc * 32 + fr, fq * 8);
#define PG8_SA(b, h) (((b) * 2 + (h)) * HTB)
#define PG8_SB(b, h) ((4 + (b) * 2 + (h)) * HTB)
#define PG8_STAGE(bufoff, gbase, voff) do { const char* _gb = (const char*)(gbase); asm volatile("" : "+s"(_gb)); _Pragma("unroll") for (int _i = 0; _i < 2; ++_i) \
        __builtin_amdgcn_global_load_lds((const unsigned*)(_gb + (voff)[_i]), (PG8_LAS unsigned*)(lds + (bufoff) + ldsw + _i * 8192), 16, 0, 0); } while (0)
#define PG8_LDA(dst, b, h) do { _Pragma("unroll") for (int m = 0; m < 4; ++m) _Pragma("unroll") for (int k = 0; k < 2; ++k) dst[m][k] = *(const PG8_LAS bf16x8*)(lds + PG8_SA(b, h) + aoff + m * 2048 + k * 1024); } while (0)
#define PG8_LDB(dst, b, h) do { _Pragma("unroll") for (int n = 0; n < 2; ++n) _Pragma("unroll") for (int k = 0; k < 2; ++k) dst[n][k] = *(const PG8_LAS bf16x8*)(lds + PG8_SB(b, h) + boff + n * 2048 + k * 1024); } while (0)
#define PG8_MMA(ai, bj, At, Bt) do { __builtin_amdgcn_s_setprio(1); _Pragma("unroll") for (int m = 0; m < 4; ++m) _Pragma("unroll") for (int n = 0; n < 2; ++n) _Pragma("unroll") for (int k = 0; k < 2; ++k) \
        acc[ai][bj][m][n] = __builtin_amdgcn_mfma_f32_16x16x32_bf16(Bt[n][k], At[m][k], acc[ai][bj][m][n], 0, 0, 0); __builtin_amdgcn_s_setprio(0); } while (0)
#define PG8_WAIT_V(n) asm volatile("s_waitcnt vmcnt(" #n ")" ::: "memory")
#define PG8_WAIT_L(n) asm volatile("s_waitcnt lgkmcnt(" #n ")" ::: "memory")
#define PG8_BAR __builtin_amdgcn_s_barrier()
#define PG8_SCHED __builtin_amdgcn_sched_barrier(0)
    Unit cur, nxt; int ui = 0;
    if (!S.next(0, cur)) return;
    f32x4 acc[2][2][4][2];
#pragma unroll
    for (int a = 0; a < 2; ++a)
#pragma unroll
        for (int b = 0; b < 2; ++b)
#pragma unroll
            for (int m = 0; m < 4; ++m)
#pragma unroll
                for (int n = 0; n < 2; ++n) acc[a][b][m][n] = (f32x4){0.f, 0.f, 0.f, 0.f};
    bf16x8 At[4][2], B0[2][2], B1[2][2];
    const char* cA = (const char*)g.A + (size_t)cur.pm * tstepA + (size_t)cur.pn * APN; const char* cB = (const char*)g.Bt + (size_t)cur.pn * tstepB;
    S.a_ready(cur);
    if constexpr (SP2) {
        PG8_STAGE(PG8_SB(0, 0), cB, voffB); PG8_STAGE(PG8_SB(0, 1), cB + hstepB, voffB); PG8_STAGE(PG8_SA(0, 0), cA, voffA); PG8_STAGE(PG8_SA(0, 1), cA + hstepA, voffA);
        if (wr == 1) PG8_BAR;
        PG8_WAIT_V(2); PG8_BAR;
        PG8_STAGE(PG8_SB(1, 0), cB + kstep, voffB); PG8_STAGE(PG8_SA(1, 0), cA + kstep, voffA); PG8_STAGE(PG8_SB(1, 1), cB + hstepB + kstep, voffB);
        PG8_WAIT_V(6); PG8_BAR;
    } else {
        PG8_STAGE(PG8_SB(0, 0), cB, voffB); PG8_STAGE(PG8_SA(0, 0), cA, voffA); PG8_STAGE(PG8_SB(0, 1), cB + hstepB, voffB); PG8_STAGE(PG8_SA(0, 1), cA + hstepA, voffA);
        if (wr == 1) PG8_BAR;
        PG8_WAIT_V(4); PG8_BAR;
        PG8_STAGE(PG8_SB(1, 0), cB + kstep, voffB); PG8_STAGE(PG8_SA(1, 0), cA + kstep, voffA); PG8_STAGE(PG8_SB(1, 1), cB + hstepB + kstep, voffB);
        PG8_WAIT_V(6); PG8_BAR;
    }
    for (;;) {
        const bool has_next = S.next(ui + 1, nxt);
        const char* nA = has_next ? (const char*)g.A + (size_t)nxt.pm * tstepA + (size_t)nxt.pn * APN : cA; const char* nB = has_next ? (const char*)g.Bt + (size_t)nxt.pn * tstepB : cB;
        for (int t = 0; t < nt; t += 2) {
            const bool last = (t == nt - 2);
            const char* a1 = cA + (size_t)(t + 1) * kstep;
            const char* a2 = last ? nA : cA + (size_t)(t + 2) * kstep; const char* b2 = last ? nB : cB + (size_t)(t + 2) * kstep;
            const char* a3 = a2 + kstep; const char* b3 = b2 + kstep;
            if (last && has_next) S.a_ready(nxt);
            if constexpr (SP2) {
            PG8_LDB(B0, 0, 0); PG8_LDB(B1, 0, 1); PG8_SCHED; PG8_LDA(At, 0, 0); PG8_STAGE(PG8_SA(1, 1), a1 + hstepA, voffA);
            PG8_WAIT_V(8); PG8_WAIT_L(0); PG8_BAR; PG8_MMA(0, 0, At, B0); PG8_MMA(0, 1, At, B1); PG8_BAR; PG8_SCHED;
            PG8_LDA(At, 0, 1); PG8_STAGE(PG8_SB(0, 0), b2, voffB); PG8_STAGE(PG8_SB(0, 1), b2 + hstepB, voffB); PG8_STAGE(PG8_SA(0, 0), a2, voffA);
            PG8_WAIT_V(8); PG8_WAIT_L(0); PG8_BAR; PG8_MMA(1, 0, At, B0); PG8_MMA(1, 1, At, B1); PG8_BAR; PG8_SCHED;
            PG8_LDB(B0, 1, 0); PG8_LDB(B1, 1, 1); PG8_SCHED; PG8_LDA(At, 1, 0); PG8_STAGE(PG8_SA(0, 1), a2 + hstepA, voffA);
            PG8_WAIT_V(8); PG8_WAIT_L(0); PG8_BAR; PG8_MMA(0, 0, At, B0); PG8_MMA(0, 1, At, B1); PG8_BAR; PG8_SCHED;
            PG8_LDA(At, 1, 1); PG8_STAGE(PG8_SB(1, 0), b3, voffB); PG8_STAGE(PG8_SB(1, 1), b3 + hstepB, voffB); PG8_STAGE(PG8_SA(1, 0), a3, voffA);
            PG8_WAIT_V(8); PG8_WAIT_L(0); PG8_BAR; PG8_MMA(1, 0, At, B0); PG8_MMA(1, 1, At, B1); PG8_BAR; PG8_SCHED;
            } else {
            PG8_LDB(B0, 0, 0); PG8_SCHED; PG8_LDA(At, 0, 0); PG8_STAGE(PG8_SA(1, 1), a1 + hstepA, voffA);
            PG8_WAIT_L(8); PG8_BAR; PG8_WAIT_L(0); PG8_MMA(0, 0, At, B0); PG8_BAR; PG8_SCHED;
            PG8_LDB(B1, 0, 1); PG8_STAGE(PG8_SB(0, 0), b2, voffB);
            PG8_BAR; PG8_WAIT_L(0); PG8_MMA(0, 1, At, B1); PG8_BAR;
            PG8_LDA(At, 0, 1); PG8_STAGE(PG8_SA(0, 0), a2, voffA);
            PG8_BAR; PG8_WAIT_L(0); PG8_MMA(1, 0, At, B0); PG8_BAR; PG8_SCHED;
            PG8_STAGE(PG8_SB(0, 1), b2 + hstepB, voffB);
            PG8_WAIT_V(6); PG8_BAR; PG8_MMA(1, 1, At, B1); PG8_BAR;
            PG8_LDB(B0, 1, 0); PG8_SCHED; PG8_LDA(At, 1, 0); PG8_STAGE(PG8_SA(0, 1), a2 + hstepA, voffA);
            PG8_WAIT_L(8); PG8_BAR; PG8_WAIT_L(0); PG8_MMA(0, 0, At, B0); PG8_BAR; PG8_SCHED;
            PG8_LDB(B1, 1, 1); PG8_STAGE(PG8_SB(1, 0), b3, voffB);
            PG8_BAR; PG8_WAIT_L(0); PG8_MMA(0, 1, At, B1); PG8_BAR;
            PG8_LDA(At, 1, 1); PG8_STAGE(PG8_SA(1, 0), a3, voffA);
            PG8_BAR; PG8_WAIT_L(0); PG8_MMA(1, 0, At, B0); PG8_BAR; PG8_SCHED;
            PG8_STAGE(PG8_SB(1, 1), b3 + hstepB, voffB);
            PG8_WAIT_V(6); PG8_BAR; PG8_MMA(1, 1, At, B1); PG8_BAR;
            }
        }
        if constexpr (ALIGN_EPI) { if (wr == 0) PG8_BAR; }
        if constexpr (!Epi::AFTER_DRAIN) { E(acc, cur, wr, wc, fr, fq); S.done(cur); }
        if (!has_next) break;
#pragma unroll
        for (int a = 0; a < 2; ++a)
#pragma unroll
            for (int b = 0; b < 2; ++b)
#pragma unroll
                for (int m = 0; m < 4; ++m)
#pragma unroll
                    for (int n = 0; n < 2; ++n) acc[a][b][m][n] = (f32x4){0.f, 0.f, 0.f, 0.f};
        cur = nxt; cA = nA; cB = nB; ++ui;
        if constexpr (ALIGN_EPI) { if (wr == 1) PG8_BAR; }
    }
    PG8_WAIT_V(0);
    if constexpr (!ALIGN_EPI) { if (wr == 0) PG8_BAR; }
    PG8_BAR;
    if constexpr (Epi::AFTER_DRAIN) { E.fused(acc, cur, wr, wc, fr, fq, lds, wid, lane); S.done(cur); }
#undef PG8_SA
#undef PG8_SB
#undef PG8_STAGE
#undef PG8_LDA
#undef PG8_LDB
#undef PG8_MMA
#undef PG8_WAIT_V
#undef PG8_WAIT_L
#undef PG8_BAR
#undef PG8_SCHED
}
}


namespace att {
using bf16 = __hip_bfloat16;
constexpr int D = 128, NW = 8, QBLK = 32, KVBLK = 64;
constexpr float SCALE = 0.088388347648318440f;
constexpr float THR = 8.f;
constexpr int SDEPTH = 2;
constexpr int LDQ = 2560, LDK = 2560, LDO = 2048;
constexpr size_t SHM_V = KVBLK * D * 2, SHM_K = KVBLK * D * 2, SHM_ATTN = 2 * SHM_V + 2 * SHM_K + NW * 64 * 4;
using bf16x8 = __attribute__((ext_vector_type(8))) short;
using s16x4  = __attribute__((ext_vector_type(4))) short;
using f32x16 = __attribute__((ext_vector_type(16))) float;
using f32x8  = __attribute__((ext_vector_type(8))) float;
using u32x4  = __attribute__((ext_vector_type(4))) unsigned;
#define KSWZ(row, colB) ((row) * 256 + ((colB) ^ (((row) & 7) << 4)))
#define SBAR() __builtin_amdgcn_sched_barrier(0)
__device__ __forceinline__ int crow(int r, int hi) { return (r & 3) + 8 * (r >> 2) + 4 * hi; }
__device__ __forceinline__ unsigned cvtpk(float lo, float hi) {
  unsigned r; asm volatile("v_cvt_pk_bf16_f32 %0, %1, %2" : "=v"(r) : "v"(lo), "v"(hi)); return r;
}
template <typename TIn> struct Stage;
template <> struct Stage<bf16>  { using T = bf16x8;
  __device__ static __forceinline__ T ld8(const bf16* p) { return *reinterpret_cast<const bf16x8*>(p); }
  __device__ static __forceinline__ bf16x8 tobf(T x) { return x; } };
template <> struct Stage<float> { using T = f32x8;
  __device__ static __forceinline__ T ld8(const float* p) { return *reinterpret_cast<const f32x8*>(p); }
  __device__ static __forceinline__ bf16x8 tobf(T x) {
    u32x4 w = {cvtpk(x[0], x[1]), cvtpk(x[2], x[3]), cvtpk(x[4], x[5]), cvtpk(x[6], x[7])}; return *reinterpret_cast<bf16x8*>(&w); } };

__device__ __forceinline__ void partialSM(f32x16& p0, f32x16& p1, float& m_reg, float& mn, float& alpha) {
  constexpr float C = SCALE * 1.4426950408889634f;
  float pmax = p0[0]; for (int r = 1; r < 16; ++r) pmax = fmaxf(pmax, p0[r]); for (int r = 0; r < 16; ++r) pmax = fmaxf(pmax, p1[r]);
  { auto rr = __builtin_amdgcn_permlane32_swap(__float_as_uint(pmax), __float_as_uint(pmax), false, false);
    pmax = fmaxf(__uint_as_float(rr[0]), __uint_as_float(rr[1])); }
  if (__builtin_expect(__all(pmax - m_reg <= THR / SCALE), 1)) { mn = m_reg; alpha = 1.f; }
  else { mn = fmaxf(m_reg, pmax); alpha = __builtin_amdgcn_exp2f((m_reg - mn) * C); m_reg = mn; }
  float mnC = -mn * C;
  for (int r = 0; r < 16; ++r) p0[r] = fmaf(p0[r], C, mnC); for (int r = 0; r < 16; ++r) p1[r] = fmaf(p1[r], C, mnC);
  for (int r = 0; r < 16; ++r) p0[r] = __builtin_amdgcn_exp2f(p0[r]);
}
__device__ __forceinline__ void finishSM(f32x16& p0, f32x16& p1, float alpha, float& l_reg, bf16x8& pa0, bf16x8& pa1, bf16x8& pa2, bf16x8& pa3) {
  for (int r = 0; r < 16; ++r) p1[r] = __builtin_amdgcn_exp2f(p1[r]);
  float ps = 0; for (int r = 0; r < 16; ++r) ps += p0[r]; for (int r = 0; r < 16; ++r) ps += p1[r];
  { auto rr = __builtin_amdgcn_permlane32_swap(__float_as_uint(ps), __float_as_uint(ps), false, false);
    ps = __uint_as_float(rr[0]) + __uint_as_float(rr[1]); }
  l_reg = l_reg * alpha + ps;
#define PK4(P, BASE, OUT) do { unsigned a0 = cvtpk(P[BASE + 0], P[BASE + 1]), a1 = cvtpk(P[BASE + 2], P[BASE + 3]);   \
    unsigned b0 = cvtpk(P[BASE + 4], P[BASE + 5]), b1 = cvtpk(P[BASE + 6], P[BASE + 7]);                              \
    auto r0 = __builtin_amdgcn_permlane32_swap(a0, b0, false, false); auto r1 = __builtin_amdgcn_permlane32_swap(a1, b1, false, false); \
    u32x4 w = {r0[0], r1[0], r0[1], r1[1]}; OUT = *reinterpret_cast<bf16x8*>(&w); } while (0)
  PK4(p0, 0, pa0); PK4(p0, 8, pa1); PK4(p1, 0, pa2); PK4(p1, 8, pa3);
#undef PK4
}
__device__ __forceinline__ void qkt(f32x16& p0, f32x16& p1, const bf16* Ks, const bf16x8* qr, int r32, int hi) {
  p0 = f32x16{}; p1 = f32x16{};
  for (int d0 = 0; d0 < 8; ++d0) { int cb = (d0 * 16 + hi * 8) * 2;
    bf16x8 b0 = *reinterpret_cast<const bf16x8*>((const char*)Ks + KSWZ(r32, cb));
    bf16x8 b1 = *reinterpret_cast<const bf16x8*>((const char*)Ks + KSWZ(32 + r32, cb));
    p0 = __builtin_amdgcn_mfma_f32_32x32x16_bf16(b0, qr[d0], p0, 0, 0, 0);
    p1 = __builtin_amdgcn_mfma_f32_32x32x16_bf16(b1, qr[d0], p1, 0, 0, 0); }
}
__device__ __forceinline__ int v_st(int k, int c) { const int kk = (k & ~0xC) | ((k & 4) << 1) | ((k & 8) >> 1); return ((kk >> 3) * 4 + (c >> 5)) * 512 + ((kk & 7) * 32 + (c & 31)) * 2; }
__device__ __forceinline__ int v_rd_base(int lane) { return ((lane & 3) << 3) | (((lane >> 2) & 3) << 6) | (((lane >> 4) & 1) << 5) | (((lane >> 5) & 1) << 8); }
constexpr int v_rd_off(int d0, int ks, int half) { return d0 * 512 + ks * 4096 + half * 2048; }
template <int OFF> __device__ __forceinline__ s16x4 tr_read(int vb) {
  s16x4 r; asm volatile("ds_read_b64_tr_b16 %0, %1 offset:%2" : "=&v"(r) : "v"(vb), "i"(OFF) : "memory"); return r;
}
template <int D0> __device__ __forceinline__ void pv_one(f32x16& od, int vb, bf16x8 pa0, bf16x8 pa1, bf16x8 pa2, bf16x8 pa3) {
  const s16x4 l0 = tr_read<v_rd_off(D0, 0, 0)>(vb), h0 = tr_read<v_rd_off(D0, 0, 1)>(vb), l1 = tr_read<v_rd_off(D0, 1, 0)>(vb), h1 = tr_read<v_rd_off(D0, 1, 1)>(vb);
  const s16x4 l2 = tr_read<v_rd_off(D0, 2, 0)>(vb), h2 = tr_read<v_rd_off(D0, 2, 1)>(vb), l3 = tr_read<v_rd_off(D0, 3, 0)>(vb), h3 = tr_read<v_rd_off(D0, 3, 1)>(vb);
  asm volatile("s_waitcnt lgkmcnt(0)" ::: "memory"); SBAR();
#define PK(L, H) (bf16x8){L[0], L[1], L[2], L[3], H[0], H[1], H[2], H[3]}
  od = __builtin_amdgcn_mfma_f32_32x32x16_bf16(pa0, PK(l0, h0), od, 0, 0, 0);
  od = __builtin_amdgcn_mfma_f32_32x32x16_bf16(pa1, PK(l1, h1), od, 0, 0, 0);
  od = __builtin_amdgcn_mfma_f32_32x32x16_bf16(pa2, PK(l2, h2), od, 0, 0, 0);
  od = __builtin_amdgcn_mfma_f32_32x32x16_bf16(pa3, PK(l3, h3), od, 0, 0, 0);
#undef PK
}
__device__ __forceinline__ void pv_d0(f32x16* o, int vb, bf16x8 pa0, bf16x8 pa1, bf16x8 pa2, bf16x8 pa3) {
  pv_one<0>(o[0], vb, pa0, pa1, pa2, pa3); pv_one<1>(o[1], vb, pa0, pa1, pa2, pa3); pv_one<2>(o[2], vb, pa0, pa1, pa2, pa3); pv_one<3>(o[3], vb, pa0, pa1, pa2, pa3);
}


template <typename TQ>
__device__ __forceinline__ void attn_dense_body(const TQ* __restrict__ Qb, const bf16* __restrict__ Kh, const bf16* __restrict__ Vh,
                                                unsigned short* __restrict__ Ob, int seq, char* lds) {
  using St = Stage<bf16>; using SQ = Stage<TQ>;
  const int tid = ltid(), wid = tid >> 6, lane = tid & 63, r32 = lane & 31, hi = lane >> 5;
  bf16* V_lds = (bf16*)lds; bf16* K_lds = (bf16*)(lds + 2 * SHM_V);
  float* ws = (float*)(lds + 2 * SHM_V + 2 * SHM_K) + wid * 64; float* li_l = ws; float* al_l = ws + 32;
  float m_reg = -1e30f, l_reg = 0; f32x16 o[4] = {}; bf16x8 qr[8];
  const TQ* Qw = Qb + (long)(wid * QBLK + r32) * LDQ + hi * 8;
#pragma unroll
  for (int d0 = 0; d0 < 8; ++d0) qr[d0] = SQ::tobf(SQ::ld8(Qw + d0 * 16));
  const int sr = tid >> 4, sc = (tid & 15) * 8, vst0 = v_st(sr, sc), vst1 = v_st(32 + sr, sc);
  const int vb0 = (int)(uintptr_t)V_lds + v_rd_base(lane);
  struct { typename St::T vs0, vs1, ks0, ks1; } sr_[SDEPTH];
#define SLOAD(i, k0) do { sr_[i].vs0 = St::ld8(&Vh[(long)((k0) + sr) * LDK + sc]); sr_[i].vs1 = St::ld8(&Vh[(long)((k0) + 32 + sr) * LDK + sc]); \
    sr_[i].ks0 = St::ld8(&Kh[(long)((k0) + sr) * LDK + sc]); sr_[i].ks1 = St::ld8(&Kh[(long)((k0) + 32 + sr) * LDK + sc]); } while (0)
#define SWRITE(b, i) do { *(bf16x8*)((char*)V_lds + (b) * SHM_V + vst0) = St::tobf(sr_[i].vs0);          \
    *(bf16x8*)((char*)V_lds + (b) * SHM_V + vst1) = St::tobf(sr_[i].vs1); int kc = sc * 2;               \
    *(bf16x8*)((char*)K_lds + (b) * SHM_K + KSWZ(sr, kc)) = St::tobf(sr_[i].ks0);                       \
    *(bf16x8*)((char*)K_lds + (b) * SHM_K + KSWZ(32 + sr, kc)) = St::tobf(sr_[i].ks1); } while (0)
#define SWAIT() do { if constexpr (SDEPTH == 2) asm volatile("s_waitcnt vmcnt(4)" ::: "memory"); else asm volatile("s_waitcnt vmcnt(0)" ::: "memory"); } while (0)
#define RESC(a) do { if (__any((a) < 1.f)) { if (hi == 0) al_l[r32] = (a); asm volatile("s_waitcnt lgkmcnt(0)" ::: "memory"); \
    for (int d = 0; d < 4; ++d) for (int r = 0; r < 16; ++r) o[d][r] *= al_l[crow(r, hi)]; } } while (0)
  f32x16 pA0, pA1, pB0, pB1; float mnA, mnB, alA, alB; bf16x8 pa0, pa1, pa2, pa3; const int NT = seq / KVBLK;
  constexpr int SE = 0, SO = SDEPTH - 1;
  SLOAD(SE, 0); asm volatile("s_waitcnt vmcnt(0)" ::: "memory"); SWRITE(0, SE); __syncthreads();
  qkt(pA0, pA1, K_lds, qr, r32, hi); partialSM(pA0, pA1, m_reg, mnA, alA);
  SLOAD(SO, KVBLK); if constexpr (SDEPTH == 2) { if (2 < NT) SLOAD(SE, 2 * KVBLK); }
  SWAIT(); SWRITE(1, SO); __syncthreads();
  for (int j = 1; j + 1 < NT; j += 2) {
    SBAR(); qkt(pB0, pB1, (bf16*)((char*)K_lds + SHM_K), qr, r32, hi);
    finishSM(pA0, pA1, alA, l_reg, pa0, pa1, pa2, pa3); SBAR();
    SLOAD(SO, (j + SDEPTH) * KVBLK); SBAR();
    pv_d0(o, vb0, pa0, pa1, pa2, pa3); partialSM(pB0, pB1, m_reg, mnB, alB);
    __syncthreads(); SWAIT(); SWRITE(0, SE);
    RESC(alB); __syncthreads();
    SBAR(); qkt(pA0, pA1, K_lds, qr, r32, hi);
    finishSM(pB0, pB1, alB, l_reg, pa0, pa1, pa2, pa3); SBAR();
    if (SDEPTH == 1 || j + 3 < NT) SLOAD(SE, (j + 1 + SDEPTH) * KVBLK); SBAR();
    pv_d0(o, vb0 + (int)SHM_V, pa0, pa1, pa2, pa3); partialSM(pA0, pA1, m_reg, mnA, alA);
    __syncthreads(); SWAIT(); SWRITE(1, SO);
    RESC(alA); __syncthreads();
  }
  SBAR(); qkt(pB0, pB1, (bf16*)((char*)K_lds + SHM_K), qr, r32, hi);
  finishSM(pA0, pA1, alA, l_reg, pa0, pa1, pa2, pa3); SBAR();
  pv_d0(o, vb0, pa0, pa1, pa2, pa3); partialSM(pB0, pB1, m_reg, mnB, alB);
  __syncthreads(); RESC(alB);
  finishSM(pB0, pB1, alB, l_reg, pa0, pa1, pa2, pa3); SBAR();
  pv_d0(o, vb0 + (int)SHM_V, pa0, pa1, pa2, pa3);
  if (hi == 0) li_l[r32] = l_reg; asm volatile("s_waitcnt lgkmcnt(0)" ::: "memory");
  float rli[16];
#pragma unroll
  for (int r = 0; r < 16; ++r) rli[r] = __builtin_amdgcn_rcpf(li_l[crow(r, hi)]);
  unsigned short* Ow = Ob + (long)(wid * QBLK) * LDO;
#pragma unroll
  for (int r = 0; r < 16; ++r) { int orow = crow(r, hi);
    for (int d0 = 0; d0 < 4; ++d0) { const float ov = o[d0][r] * rli[r]; Ow[(long)orow * LDO + d0 * 32 + r32] = (unsigned short)cvtpk(ov, ov); } }
#undef SLOAD
#undef SWRITE
#undef SWAIT
#undef RESC
}


}

typedef unsigned short bf16_t;
typedef float f32x4 __attribute__((ext_vector_type(4)));
typedef unsigned u32x4 __attribute__((ext_vector_type(4)));
typedef unsigned u32x2 __attribute__((ext_vector_type(2)));
constexpr int MTOK = 16384, DM = 2048, ABIN = 8192, CDIN = 2560, FFH = 5632, SEQ = 2048;
constexpr int NPH = 33;
constexpr float DN_ALPHA = 1.6817928305074290f;
constexpr size_t WS_ABIN = 0;
constexpr size_t WS_ABOUT = WS_ABIN + 2ull * ABIN * DM * 2;
constexpr size_t WS_CDIN = WS_ABOUT + 2ull * DM * DM * 2;
constexpr size_t WS_CDOUT = WS_CDIN + 2ull * CDIN * DM * 2;
constexpr size_t WS_POOL = WS_CDOUT + 2ull * DM * DM * 2;
constexpr size_t WS_GU = WS_POOL + 2ull * 4 * 256 * 256 * 2;
constexpr size_t WS_DOWN = WS_GU + 4ull * 2 * FFH * DM * 2;
constexpr size_t WS_XB = WS_DOWN + 4ull * DM * FFH * 2;
constexpr size_t WS_R = WS_XB + (size_t)MTOK * DM * 2;
constexpr size_t R_POOLED = (size_t)MTOK * CDIN * 2;
constexpr size_t R_MIX = (size_t)MTOK * ABIN * 2;
constexpr size_t R_Y2 = (size_t)MTOK * FFH * 2;
constexpr size_t WS_END = WS_R + R_MIX + (size_t)MTOK * DM * 2;
constexpr size_t WS_BAR = WS_END; constexpr size_t WS_OB = WS_BAR + 16384; constexpr size_t WS_XCH = WS_OB + (size_t)MTOK * 1024 * 4;
constexpr size_t WS_TOTAL = WS_XCH + (size_t)MTOK * 2 * 4;
constexpr int LDS_BYTES = 151552 + 16;

struct Params { const float* in[19]; float* out; unsigned char* ws; int ph_lo, ph_hi; };

__device__ __forceinline__ float bflo(unsigned w) { return __uint_as_float(w << 16); }
__device__ __forceinline__ float bfhi(unsigned w) { return __uint_as_float(w & 0xffff0000u); }
__device__ __forceinline__ unsigned pk2(float lo, float hi) { return pg8::cvt_pk_bf16(lo, hi); }
typedef float f32x2c_t __attribute__((ext_vector_type(2))); typedef __bf16 bf16x2c_t __attribute__((ext_vector_type(2)));
__device__ __forceinline__ unsigned pk2s(float lo, float hi) { f32x2c_t v = {lo, hi}; bf16x2c_t b = __builtin_convertvector(v, bf16x2c_t); return __builtin_bit_cast(unsigned, b); }
__device__ __forceinline__ float sigmoidf_(float z) { return 1.0f / (1.0f + __expf(-z)); }
template <int M> __device__ __forceinline__ float swz_xor(float v) { return __int_as_float(__builtin_amdgcn_ds_swizzle(__float_as_int(v), (M << 10) | 0x1f)); }
__device__ __forceinline__ float sum32(float v) { auto r = __builtin_amdgcn_permlane32_swap(__float_as_uint(v), __float_as_uint(v), false, false); return __uint_as_float(r[0]) + __uint_as_float(r[1]); }
__device__ __forceinline__ float max32(float v) { auto r = __builtin_amdgcn_permlane32_swap(__float_as_uint(v), __float_as_uint(v), false, false); return fmaxf(__uint_as_float(r[0]), __uint_as_float(r[1])); }
__device__ __forceinline__ float sum_lo32(float v) { v += swz_xor<16>(v); v += swz_xor<8>(v); v += swz_xor<4>(v); v += swz_xor<2>(v); v += swz_xor<1>(v); return v; }
__device__ __forceinline__ float wave_sum(float v) { return sum_lo32(sum32(v)); }
__device__ __forceinline__ float wave_max(float v) { v = max32(v); v = fmaxf(v, swz_xor<16>(v)); v = fmaxf(v, swz_xor<8>(v)); v = fmaxf(v, swz_xor<4>(v)); v = fmaxf(v, swz_xor<2>(v)); v = fmaxf(v, swz_xor<1>(v)); return v; }
#define LDS_FENCE() asm volatile("s_waitcnt lgkmcnt(0)" ::: "memory")

__device__ __forceinline__ void cvt_tr(const float* __restrict__ src, int K, int N, bf16_t* __restrict__ dst, int ldd, int mode, float* tile, int bid, int nb) {
    const int tid = ltid(), tn = N >> 6, nt = tn * (K >> 7);
    const int kr0 = tid >> 4, nc = (tid & 15) * 4;
    f32x4 r[4];
    if (bid < nt) { const int kt = bid / tn, k0 = kt * 128, n0 = (bid - kt * tn) * 64;
#pragma unroll
        for (int i = 0; i < 4; ++i) r[i] = *(const f32x4*)(src + (size_t)(k0 + kr0 + 32 * i) * N + n0 + nc); }
    for (int t = bid; t < nt; t += nb) {
        const int kt = t / tn, k0 = kt * 128, n0 = (t - kt * tn) * 64;
#pragma unroll
        for (int i = 0; i < 4; ++i) { float* tp = tile + (kr0 + 32 * i) * 65 + nc; tp[0] = r[i][0]; tp[1] = r[i][1]; tp[2] = r[i][2]; tp[3] = r[i][3]; }
        __syncthreads();
        if (t + nb < nt) { const int t2 = t + nb, kt2 = t2 / tn, k2 = kt2 * 128, n2 = (t2 - kt2 * tn) * 64;
#pragma unroll
            for (int i = 0; i < 4; ++i) r[i] = *(const f32x4*)(src + (size_t)(k2 + kr0 + 32 * i) * N + n2 + nc); }
        const int nr = tid >> 3, kc = (tid & 7) * 16;
        float v[16];
#pragma unroll
        for (int i = 0; i < 16; ++i) v[i] = tile[(kc + i) * 65 + nr];
        const int n = n0 + nr; const int drow = mode == 0 ? n : ((n >> 7) * 256 + (n & 127) + (mode == 2 ? 128 : 0));
        u32x4 w0, w1; w0.x = pk2(v[0], v[1]); w0.y = pk2(v[2], v[3]); w0.z = pk2(v[4], v[5]); w0.w = pk2(v[6], v[7]);
        w1.x = pk2(v[8], v[9]); w1.y = pk2(v[10], v[11]); w1.z = pk2(v[12], v[13]); w1.w = pk2(v[14], v[15]);
        bf16_t* dp = dst + (size_t)drow * ldd + k0 + kc; *(u32x4*)dp = w0; *(u32x4*)(dp + 8) = w1;
        __syncthreads();
    }
}

__device__ __forceinline__ void ln_phase(float* __restrict__ X, bf16_t* __restrict__ xb, const float* __restrict__ g, const float* __restrict__ b, float* __restrict__ st, bool writeX) {
    const int lane = ltid() & 63, wid = ltid() >> 6;
    for (int row = (lbid() * 8 + wid) * 4; row < MTOK; row += lgdim() * 32) {
        const size_t ro = (size_t)row * DM;
        f32x4 v[4][8]; float s[4] = {0.f, 0.f, 0.f, 0.f};
#pragma unroll
        for (int rr = 0; rr < 4; ++rr)
#pragma unroll
            for (int i = 0; i < 8; ++i) { const int c = (i * 64 + lane) * 4; v[rr][i] = *(const f32x4*)(X + ro + rr * DM + c); }
#pragma unroll
        for (int rr = 0; rr < 4; ++rr)
#pragma unroll
            for (int i = 0; i < 8; ++i) s[rr] += (v[rr][i][0] + v[rr][i][1]) + (v[rr][i][2] + v[rr][i][3]);
        float rstd[4];
#pragma unroll
        for (int rr = 0; rr < 4; ++rr) { const float mean = wave_sum(s[rr]) * (1.0f / DM); float q = 0.f;
#pragma unroll
            for (int i = 0; i < 8; ++i) { v[rr][i] = v[rr][i] - mean; q += (v[rr][i][0] * v[rr][i][0] + v[rr][i][1] * v[rr][i][1]) + (v[rr][i][2] * v[rr][i][2] + v[rr][i][3] * v[rr][i][3]); }
            rstd[rr] = rsqrtf(wave_sum(q) * (1.0f / DM) + 1e-5f);
            if (lane == 0) { st[2 * (row + rr)] = mean; st[2 * (row + rr) + 1] = rstd[rr]; } }
#pragma unroll
        for (int i = 0; i < 8; ++i) { const int c = (i * 64 + lane) * 4; const f32x4 gv = *(const f32x4*)(g + c), bv = *(const f32x4*)(b + c);
#pragma unroll
            for (int rr = 0; rr < 4; ++rr) { const f32x4 o = v[rr][i] * rstd[rr] * gv + bv; if (writeX) *(f32x4*)(X + ro + rr * DM + c) = o;
                u32x2 w; w.x = pk2(o[0], o[1]); w.y = pk2(o[2], o[3]); *(u32x2*)(xb + ro + rr * DM + c) = w; } }
    }
}

typedef short s16x8 __attribute__((ext_vector_type(8)));
typedef float f32x2g __attribute__((ext_vector_type(2)));
#define MFMA16(a, b, c) __builtin_amdgcn_mfma_f32_16x16x32_bf16(a, b, c, 0, 0, 0)
__device__ __forceinline__ s16x8 mk8(unsigned a, unsigned b, unsigned c, unsigned d) { u32x4 w = {a, b, c, d}; return *reinterpret_cast<s16x8*>(&w); }
__device__ __forceinline__ float clamp80(float x) { return fminf(fmaxf(x, -80.f), 80.f); }
constexpr int HD_TOT_OFF = 72704;
__device__ __forceinline__ void hgrn_dir(const bf16_t* __restrict__ proj, const float* __restrict__ lbl, int jl, float* odir, int bh, int dir, __attribute__((address_space(3))) unsigned char* lds,
                                         const float* of, const float* ob, const float* __restrict__ normw, bf16_t* __restrict__ mixout, unsigned* cnt) {
    typedef __attribute__((address_space(3))) unsigned char* L3p; typedef __attribute__((address_space(3))) bf16_t* L3h; typedef __attribute__((address_space(3))) float* L3f;
    typedef __attribute__((address_space(3))) u32x4* L3q;
    const int tid = ltid(), wv = __builtin_amdgcn_readfirstlane(tid >> 6), lane0 = tid & 63;
    const int b = bh >> 3, h = bh & 7;
    const L3p L = (L3p)lds;
    const L3f eRv = (L3f)L; const L3f eLv = eRv + 128;
    const L3h Qd = (L3h)(L + 1024); const L3h Kd = (L3h)(L + 18432); const L3h Pm = Kd; const L3h KdT = (L3h)(L + 35840); const L3h VT = (L3h)(L + 54272);
    const L3f tot = (L3f)(L + HD_TOT_OFF);
    float lb0 = 0.f, lb1 = 0.f;
    if (jl != 0) { const int ch = h * 128 + 2 * lane0; const f32x2g l0 = *(const f32x2g*)(lbl + ch), l1 = *(const f32x2g*)(lbl + 1024 + ch);
        { const float mx = fmaxf(l0.x, l1.x), e0 = __expf(l0.x - mx), e1 = __expf(l1.x - mx); lb0 = e1 / (e0 + e1); }
        { const float mx = fmaxf(l0.y, l1.y), e0 = __expf(l0.y - mx), e1 = __expf(l1.y - mx); lb1 = e1 / (e0 + e1); } }
    const float om0 = 1.f - lb0, om1 = 1.f - lb1;
    const size_t tok0 = (size_t)b * SEQ;
    const bf16_t* pbase = proj + h * 128 + 2 * lane0;
    const int zoff = dir ? 5120 : 4096;
    unsigned zr[8], qr[8], vr[8];
    f32x4 S[8];
#pragma unroll
    for (int i = 0; i < 8; ++i) S[i] = (f32x4){0.f, 0.f, 0.f, 0.f};
#define HD_T(k_, tau_) (dir ? ((31 - (k_)) * 64 + 63 - (tau_)) : ((k_) * 64 + (tau_)))
#define HD_LOAD(k_) do { _Pragma("unroll") for (int i = 0; i < 8; ++i) { const bf16_t* rp = pbase + (tok0 + HD_T(k_, 8 * wv + i)) * ABIN; \
        zr[i] = *(const unsigned*)(rp + zoff); qr[i] = *(const unsigned*)(rp + 3072); vr[i] = *(const unsigned*)(rp + 6144); } } while (0)
    HD_LOAD(0);
    for (int k = 0; k < 32; ++k) {
        int lane = lane0; asm volatile("" : "+v"(lane)); const int fr = lane & 15, fq = lane >> 4;
        float g0[8], g1[8]; unsigned kpk[8]; float T0 = 0.f, T1 = 0.f;
#pragma unroll
        for (int i = 0; i < 8; ++i) { const float s0 = bflo(zr[i]), s1 = bfhi(zr[i]);
            T0 += __logf(lb0 + om0 * s0); T1 += __logf(lb1 + om1 * s1); g0[i] = T0; g1[i] = T1; kpk[i] = pk2(om0 * (1.f - s0), om1 * (1.f - s1)); }
        *(__attribute__((address_space(3))) f32x2g*)(tot + wv * 128 + 2 * lane) = (f32x2g){T0, T1};
        __syncthreads();
        { float p0 = 0.f, p1 = 0.f, R0 = 0.f, R1 = 0.f, GL0 = 0.f, GL1 = 0.f;
#pragma unroll
          for (int q = 0; q < 8; ++q) { const f32x2g tq_ = *(const __attribute__((address_space(3))) f32x2g*)(tot + q * 128 + 2 * lane);
              if (q < wv) { p0 += tq_.x; p1 += tq_.y; } if (q < 4) { R0 += tq_.x; R1 += tq_.y; } GL0 += tq_.x; GL1 += tq_.y; }
          const float eLR0 = __expf(clamp80(GL0 - R0)), eLR1 = __expf(clamp80(GL1 - R1));
          if (wv == 0) { *(__attribute__((address_space(3))) f32x2g*)(eRv + 2 * lane) = (f32x2g){__expf(R0), __expf(R1)}; *(__attribute__((address_space(3))) f32x2g*)(eLv + 2 * lane) = (f32x2g){__expf(GL0), __expf(GL1)}; }
          unsigned kt0[4], kt1[4], vt0[4], vt1[4];
#pragma unroll
          for (int i = 0; i < 8; i += 2) { float kk0[2], kk1[2];
#pragma unroll
              for (int e = 0; e < 2; ++e) { const int ii = i + e;
                  const float E0 = __expf(clamp80(p0 + g0[ii] - R0)), E1 = __expf(clamp80(p1 + g1[ii] - R1));
                  const float qs0 = bflo(qr[ii]), qs1 = bfhi(qr[ii]);
                  const float kd0 = bflo(kpk[ii]) * __builtin_amdgcn_rcpf(E0), kd1 = bfhi(kpk[ii]) * __builtin_amdgcn_rcpf(E1);
                  *(__attribute__((address_space(3))) unsigned*)(Qd + (8 * wv + ii) * 136 + 2 * lane) = pk2(qs0 * E0, qs1 * E1);
                  *(__attribute__((address_space(3))) unsigned*)(Kd + (8 * wv + ii) * 136 + 2 * lane) = pk2(kd0, kd1);
                  kk0[e] = kd0 * eLR0; kk1[e] = kd1 * eLR1; }
              kt0[i >> 1] = pk2(kk0[0], kk0[1]); kt1[i >> 1] = pk2(kk1[0], kk1[1]);
              vt0[i >> 1] = (vr[i] & 0xffffu) | (vr[i + 1] << 16); vt1[i >> 1] = (vr[i] >> 16) | (vr[i + 1] & 0xffff0000u); }
          const L3h kp0 = KdT + (2 * lane) * 72 + 8 * wv; const L3h vp0 = VT + (2 * lane) * 72 + 8 * wv;
          *(L3q)kp0 = (u32x4){kt0[0], kt0[1], kt0[2], kt0[3]}; *(L3q)(kp0 + 72) = (u32x4){kt1[0], kt1[1], kt1[2], kt1[3]};
          *(L3q)vp0 = (u32x4){vt0[0], vt0[1], vt0[2], vt0[3]}; *(L3q)(vp0 + 72) = (u32x4){vt1[0], vt1[1], vt1[2], vt1[3]}; }
        if (k + 1 < 32) HD_LOAD(k + 1);
        __syncthreads();
        const int tb_ = wv & 3, sb0 = 2 * (wv >> 2);
        unsigned pw[2][2];
        { s16x8 qf[4];
#pragma unroll
          for (int ks = 0; ks < 4; ++ks) qf[ks] = *(const __attribute__((address_space(3))) s16x8*)(Qd + (16 * tb_ + fr) * 136 + 32 * ks + 8 * fq);
#pragma unroll
          for (int si = 0; si < 2; ++si) { const int sb = sb0 + si; f32x4 a = {0.f, 0.f, 0.f, 0.f};
              if (sb <= tb_) {
#pragma unroll
                  for (int ks = 0; ks < 4; ++ks) { const s16x8 kf = *(const __attribute__((address_space(3))) s16x8*)(Kd + (16 * sb + fr) * 136 + 32 * ks + 8 * fq); a = MFMA16(kf, qf[ks], a); }
                  if (sb == tb_) {
#pragma unroll
                      for (int r = 0; r < 4; ++r) if (4 * fq + r > fr) a[r] = 0.f; } }
              pw[si][0] = pk2s(a[0], a[1]); pw[si][1] = pk2s(a[2], a[3]); } }
        __syncthreads();
#pragma unroll
        for (int si = 0; si < 2; ++si) *(__attribute__((address_space(3))) u32x2*)(Pm + (16 * tb_ + fr) * 72 + 16 * (sb0 + si) + 4 * fq) = (u32x2){pw[si][0], pw[si][1]};
        f32x4 oacc[4];
#pragma unroll
        for (int tb = 0; tb < 4; ++tb) oacc[tb] = (f32x4){0.f, 0.f, 0.f, 0.f};
#pragma unroll
        for (int ks = 0; ks < 4; ++ks) {
            const f32x4 ea = *(const __attribute__((address_space(3))) f32x4*)(eRv + 32 * ks + 4 * fq), eb = *(const __attribute__((address_space(3))) f32x4*)(eRv + 32 * ks + 16 + 4 * fq);
            const f32x4 a = S[2 * ks] * ea, c = S[2 * ks + 1] * eb; const s16x8 xf = mk8(pk2(a[0], a[1]), pk2(a[2], a[3]), pk2(c[0], c[1]), pk2(c[2], c[3]));
#pragma unroll
            for (int tb = 0; tb < 4; ++tb) { const u32x2 qa = *(const __attribute__((address_space(3))) u32x2*)(Qd + (16 * tb + fr) * 136 + 32 * ks + 4 * fq), qb = *(const __attribute__((address_space(3))) u32x2*)(Qd + (16 * tb + fr) * 136 + 32 * ks + 16 + 4 * fq);
                oacc[tb] = MFMA16(xf, mk8(qa.x, qa.y, qb.x, qb.y), oacc[tb]); } }
        __syncthreads();
        s16x8 vf[2];
#pragma unroll
        for (int ks2 = 0; ks2 < 2; ++ks2) vf[ks2] = *(const __attribute__((address_space(3))) s16x8*)(VT + (16 * wv + fr) * 72 + 32 * ks2 + 8 * fq);
#pragma unroll
        for (int tb = 0; tb < 4; ++tb)
#pragma unroll
            for (int ks2 = 0; ks2 < 2; ++ks2) if (ks2 <= (tb >> 1)) { const s16x8 pf = *(const __attribute__((address_space(3))) s16x8*)(Pm + (16 * tb + fr) * 72 + 32 * ks2 + 8 * fq);
                oacc[tb] = MFMA16(vf[ks2], pf, oacc[tb]); }
#pragma unroll
        for (int tb = 0; tb < 4; ++tb) { const size_t token = tok0 + HD_T(k, 16 * tb + fr); *(f32x4*)(odir + token * 1024 + h * 128 + 16 * wv + 4 * fq) = oacc[tb]; }
#pragma unroll
        for (int blk = 0; blk < 8; ++blk) { const f32x4 el = *(const __attribute__((address_space(3))) f32x4*)(eLv + 16 * blk + 4 * fq);
            S[blk] = S[blk] * el;
#pragma unroll
            for (int ks2 = 0; ks2 < 2; ++ks2) { const s16x8 kf = *(const __attribute__((address_space(3))) s16x8*)(KdT + (16 * blk + fr) * 72 + 32 * ks2 + 8 * fq); S[blk] = MFMA16(kf, vf[ks2], S[blk]); } }
    }
    asm volatile("s_waitcnt vmcnt(0)" ::: "memory");
    __threadfence();
    asm volatile("s_waitcnt vmcnt(0)" ::: "memory");
    __syncthreads();
    const __attribute__((address_space(3))) unsigned* flag = (const __attribute__((address_space(3))) unsigned*)(L + HD_TOT_OFF + 4096);
    if (tid == 0) *(__attribute__((address_space(3))) unsigned*)(L + HD_TOT_OFF + 4096) = __hip_atomic_fetch_add(cnt + bh, 1u, __ATOMIC_RELAXED, __HIP_MEMORY_SCOPE_AGENT);
    __syncthreads();
    if (*flag == 1u) {
        __threadfence();
        asm volatile("s_waitcnt vmcnt(0)" ::: "memory");
        __syncthreads();
        for (int it0 = tid; it0 < SEQ * 32; it0 += 8 * 512) {
            f32x4 o[8]; u32x2 gw[8];
#pragma unroll
            for (int u = 0; u < 8; ++u) { const int it = it0 + u * 512; const size_t token = tok0 + (it >> 5); const int col = h * 128 + (it & 31) * 4;
                o[u] = *(const f32x4*)(of + token * 1024 + col) + *(const f32x4*)(ob + token * 1024 + col); gw[u] = *(const u32x2*)(proj + token * ABIN + 7168 + col); }
#pragma unroll
            for (int u = 0; u < 8; ++u) { const int it = it0 + u * 512; const size_t token = tok0 + (it >> 5); const int col = h * 128 + (it & 31) * 4;
                float ss = (o[u][0] * o[u][0] + o[u][1] * o[u][1]) + (o[u][2] * o[u][2] + o[u][3] * o[u][3]);
                ss = sum_lo32(ss);
                const float rs = rsqrtf(ss * (1.0f / 128.0f) + 1e-6f);
                const f32x4 nw = *(const f32x4*)(normw + col);
                const float gg[4] = {bflo(gw[u].x), bfhi(gw[u].x), bflo(gw[u].y), bfhi(gw[u].y)}; float r[4];
#pragma unroll
                for (int i = 0; i < 4; ++i) r[i] = o[u][i] * rs * nw[i] * gg[i] * __builtin_amdgcn_rcpf(1.f + __expf(-gg[i]));
                *(u32x2*)(mixout + token * DM + 1024 + col) = (u32x2){pk2(r[0], r[1]), pk2(r[2], r[3])}; }
        }
    }
    __syncthreads();
#undef HD_T
#undef HD_LOAD
}
__device__ __forceinline__ void hgrn_combine(const float* __restrict__ of, const float* __restrict__ ob, const bf16_t* __restrict__ proj, const float* __restrict__ normw, bf16_t* __restrict__ mixout) {
    const long stride = (long)lgdim() * 512;
    for (long it0 = (long)lbid() * 512 + ltid(); it0 < (long)MTOK * 256; it0 += 4 * stride) {
        f32x4 o[4]; u32x2 gw[4];
#pragma unroll
        for (int u = 0; u < 4; ++u) { const long it = it0 + u * stride; if (it < (long)MTOK * 256) { const size_t token = (size_t)(it >> 8); const int col = (int)(it & 255) * 4;
            o[u] = *(const f32x4*)(of + token * 1024 + col) + *(const f32x4*)(ob + token * 1024 + col); gw[u] = *(const u32x2*)(proj + token * ABIN + 7168 + col); } else { o[u] = (f32x4){0.f, 0.f, 0.f, 0.f}; gw[u] = (u32x2){0u, 0u}; } }
#pragma unroll
        for (int u = 0; u < 4; ++u) { const long it = it0 + u * stride; const size_t token = (size_t)(it >> 8); const int col = (int)(it & 255) * 4;
            float ss = (o[u][0] * o[u][0] + o[u][1] * o[u][1]) + (o[u][2] * o[u][2] + o[u][3] * o[u][3]);
            ss = sum_lo32(ss);
            const float rs = rsqrtf(ss * (1.0f / 128.0f) + 1e-6f);
            const f32x4 nw = *(const f32x4*)(normw + col);
            const float gg[4] = {bflo(gw[u].x), bfhi(gw[u].x), bflo(gw[u].y), bfhi(gw[u].y)}; float r[4];
#pragma unroll
            for (int i = 0; i < 4; ++i) r[i] = o[u][i] * rs * nw[i] * gg[i] * __builtin_amdgcn_rcpf(1.f + __expf(-gg[i]));
            if (it < (long)MTOK * 256) *(u32x2*)(mixout + token * DM + 1024 + col) = (u32x2){pk2(r[0], r[1]), pk2(r[2], r[3])}; }
    }
}

constexpr int NA_VT_BYTES = 2 * 128 * 72 * 2;
constexpr int NA_RPB_OFF = 2 * NA_VT_BYTES;
__device__ __forceinline__ void na_mfma(const bf16_t* __restrict__ proj, const float* __restrict__ rpb, bf16_t* __restrict__ mixout, int unit0, int ustride, __attribute__((address_space(3))) unsigned char* lds) {
    typedef __attribute__((address_space(3))) unsigned char* L3p; typedef __attribute__((address_space(3))) bf16_t* L3h; typedef __attribute__((address_space(3))) float* L3f;
    const int tid = ltid(), wv = __builtin_amdgcn_readfirstlane(tid >> 6), hd = wv >> 2, g = wv & 3, lane = tid & 63, fr = lane & 15, fq = lane >> 4;
    const L3f rl = (L3f)(lds + NA_RPB_OFF);
    for (int i = tid; i < 8 * 465; i += 512) rl[i] = rpb[i];
    const int cw = (g == 0) ? 0 : (g == 1) ? 8 : (g == 2) ? 24 : 32;
    const int c = 16 * g + fr, cs = min(max(c - 8, 0), 48);
    const int skp = tid & 31, spart = tid >> 5, shead = spart >> 3, sd0 = (spart & 7) * 16;
    __syncthreads();
    for (int unit = unit0; unit < 1024; unit += ustride) {
        const int hp = unit & 3, r = (unit >> 2) & 31, b = unit >> 7, h = hp * 2 + hd, r0 = min(max(r - 4, 0), 24);
        const size_t tokq = (size_t)b * SEQ + r * 64 + c;
        s16x8 qf[4];
#pragma unroll
        for (int ks = 0; ks < 4; ++ks) qf[ks] = *(const s16x8*)(proj + tokq * ABIN + h * 128 + 32 * ks + 8 * fq);
        const bf16_t* vsrc = proj + ((size_t)b * SEQ + r0 * 64 + 2 * skp) * ABIN + 2048 + (hp * 2 + shead) * 128 + sd0;
        u32x4 vreg[2][4];
#pragma unroll
        for (int q = 0; q < 4; ++q) { vreg[0][q] = *(const u32x4*)(vsrc + (size_t)(q >> 1) * ABIN + 8 * (q & 1)); vreg[1][q] = *(const u32x4*)(vsrc + (size_t)(64 + (q >> 1)) * ABIN + 8 * (q & 1)); }
        f32x4 sc[8][2];
        const bf16_t* kbase = proj + ((size_t)b * SEQ + r0 * 64 + cw + 8 * (fr >> 2) + (fr & 3)) * ABIN + 1024 + h * 128 + 8 * fq;
#pragma unroll
        for (int j = 0; j < 8; ++j)
#pragma unroll
            for (int hf = 0; hf < 2; ++hf) { f32x4 a = {0.f, 0.f, 0.f, 0.f};
#pragma unroll
                for (int ks = 0; ks < 4; ++ks) { const s16x8 kf = *(const s16x8*)(kbase + (size_t)(j * 64 + 4 * hf) * ABIN + 32 * ks); a = MFMA16(kf, qf[ks], a); }
                sc[j][hf] = a; }
        float mx = -3.0e38f;
#pragma unroll
        for (int j = 0; j < 8; ++j) { const int ro = h * 465 + (r0 + j - r + 7) * 31 + 15 - c;
#pragma unroll
            for (int hf = 0; hf < 2; ++hf)
#pragma unroll
                for (int e = 0; e < 4; ++e) { const int kc = cw + 8 * fq + 4 * hf + e; const bool ok = (kc >= cs) && (kc < cs + 16);
                    const float bias = rl[ok ? (ro + kc) : 0];
                    const float s = ok ? (sc[j][hf][e] * 0.088388347648318440f + bias) : -3.0e38f; sc[j][hf][e] = s; mx = fmaxf(mx, s); } }
        mx = fmaxf(mx, swz_xor<16>(mx)); mx = max32(mx);
        float sum = 0.f; s16x8 pf[8];
#pragma unroll
        for (int j = 0; j < 8; ++j) { float p[8];
#pragma unroll
            for (int hf = 0; hf < 2; ++hf)
#pragma unroll
                for (int e = 0; e < 4; ++e) { const float pv = __expf(sc[j][hf][e] - mx); p[hf * 4 + e] = pv; sum += pv; }
            pf[j] = mk8(pk2(p[0], p[1]), pk2(p[2], p[3]), pk2(p[4], p[5]), pk2(p[6], p[7])); }
        sum += swz_xor<16>(sum); sum = sum32(sum);
        const float inv = 1.0f / sum;
        f32x4 oacc[8];
#pragma unroll
        for (int db = 0; db < 8; ++db) oacc[db] = (f32x4){0.f, 0.f, 0.f, 0.f};
#pragma unroll
        for (int j = 0; j < 8; ++j) {
            const L3h vt = (L3h)(lds + (j & 1) * NA_VT_BYTES) + shead * (128 * 72) + sd0 * 72 + 2 * skp;
#pragma unroll
            for (int hh = 0; hh < 2; ++hh) { const unsigned a[4] = {vreg[j & 1][hh].x, vreg[j & 1][hh].y, vreg[j & 1][hh].z, vreg[j & 1][hh].w}, c[4] = {vreg[j & 1][2 + hh].x, vreg[j & 1][2 + hh].y, vreg[j & 1][2 + hh].z, vreg[j & 1][2 + hh].w};
#pragma unroll
                for (int e = 0; e < 4; ++e) { *(__attribute__((address_space(3))) unsigned*)(vt + (8 * hh + 2 * e) * 72) = (a[e] & 0xffffu) | (c[e] << 16);
                    *(__attribute__((address_space(3))) unsigned*)(vt + (8 * hh + 2 * e + 1) * 72) = (a[e] >> 16) | (c[e] & 0xffff0000u); } }
            __syncthreads();
            if (j + 2 < 8) {
#pragma unroll
                for (int q = 0; q < 4; ++q) vreg[j & 1][q] = *(const u32x4*)(vsrc + (size_t)((j + 2) * 64 + (q >> 1)) * ABIN + 8 * (q & 1)); }
            const L3h vr = (L3h)(lds + (j & 1) * NA_VT_BYTES) + hd * (128 * 72) + fr * 72 + cw + 8 * fq;
#pragma unroll
            for (int db = 0; db < 8; ++db) oacc[db] = MFMA16(*(const __attribute__((address_space(3))) s16x8*)(vr + db * 16 * 72), pf[j], oacc[db]);
        }
        bf16_t* op = mixout + tokq * DM + h * 128 + 4 * fq;
#pragma unroll
        for (int db = 0; db < 8; ++db) { const f32x4 o = oacc[db] * inv; *(u32x2*)(op + 16 * db) = (u32x2){pk2(o[0], o[1]), pk2(o[2], o[3])}; }
        __syncthreads();
    }
}

__device__ __forceinline__ void cd_prep(bf16_t* __restrict__ proj, const float* __restrict__ qn, const float* __restrict__ kn, bf16_t* __restrict__ pooled) {
    const int tid = ltid(), lane = tid & 63, wid = tid >> 6;
    const int nw = lgdim() * 8, w0 = lbid() * 8 + wid;
    { const int f = lane & 31; const float inv = exp2f(-(float)f * (13.287712379549449f / 32.0f));
      for (int it0 = w0; it0 < MTOK * 10; it0 += 4 * nw) {
        unsigned w[4];
#pragma unroll
        for (int u = 0; u < 4; ++u) { const int it = it0 + u * nw; const int token = it / 10, hh = it - token * 10;
            w[u] = (it < MTOK * 10) ? *(const unsigned*)(proj + (size_t)token * CDIN + 1024 + hh * 128 + 2 * lane) : 0u; }
#pragma unroll
        for (int u = 0; u < 4; ++u) { const int it = it0 + u * nw; const int token = it / 10, hh = it - token * 10, t = token & 2047;
            const float x0 = bflo(w[u]), x1 = bfhi(w[u]);
            const float ms = wave_sum(x0 * x0 + x1 * x1) * (1.0f / 128.0f), rs = rsqrtf(ms + 1e-6f);
            const float* gp = (hh < 8 ? qn : kn) + 2 * lane;
            const float n0 = x0 * rs * gp[0], n1 = x1 * rs * gp[1];
            const float pos = (lane < 32) ? (float)(t >> 6) : (float)(t & 63);
            const float ang = pos * inv, kk = rintf(ang * 0.15915494309189535f); float rr = fmaf(-kk, 6.2831854820251465f, ang); rr = fmaf(kk, 1.7484555e-07f, rr); const float sn = __sinf(rr), cs = __cosf(rr);
            if (it < MTOK * 10) *(unsigned*)(proj + (size_t)token * CDIN + 1024 + hh * 128 + 2 * lane) = pk2(n0 * cs - n1 * sn, n0 * sn + n1 * cs); } } }
    for (long it = (long)lbid() * 512 + tid; it < (long)MTOK * 128; it += (long)lgdim() * 512) {
        const int token = (int)(it >> 7), ch = (int)(it & 127) * 8, t = token & 2047, hw = 1 << (ch >> 8);
        const int lo = max(t - hw, 0), hi = min(t + hw, SEQ);
        const bf16_t* cp = proj + (size_t)(token - t) * CDIN + ch;
        u32x4 wv[16];
#pragma unroll
        for (int k = 0; k < 16; ++k) { const int tt = t - hw + k; const bool ok = (k < 2 * hw) && (tt >= 0) && (tt < SEQ); wv[k] = ok ? *(const u32x4*)(cp + (size_t)tt * CDIN) : (u32x4){0u, 0u, 0u, 0u}; }
        const u32x4 xw = *(const u32x4*)(cp + (size_t)t * CDIN);
        float s[8];
#pragma unroll
        for (int i = 0; i < 8; ++i) s[i] = 0.f;
#pragma unroll
        for (int k = 0; k < 16; ++k) { s[0] += bflo(wv[k].x); s[1] += bfhi(wv[k].x); s[2] += bflo(wv[k].y); s[3] += bfhi(wv[k].y); s[4] += bflo(wv[k].z); s[5] += bfhi(wv[k].z); s[6] += bflo(wv[k].w); s[7] += bfhi(wv[k].w); }
        const float rn = 1.0f / (float)(hi - lo);
        const float xs[8] = {bflo(xw.x), bfhi(xw.x), bflo(xw.y), bfhi(xw.y), bflo(xw.z), bfhi(xw.z), bflo(xw.w), bfhi(xw.w)};
        u32x4 o; o.x = pk2(s[0] * rn - xs[0], s[1] * rn - xs[1]); o.y = pk2(s[2] * rn - xs[2], s[3] * rn - xs[3]); o.z = pk2(s[4] * rn - xs[4], s[5] * rn - xs[5]); o.w = pk2(s[6] * rn - xs[6], s[7] * rn - xs[7]);
        *(u32x4*)(pooled + (size_t)token * 1024 + ch) = o;
    }
}


#define XB_TMO      128
#define XB_XCNT(j)  (256  + 64 * (j))
#define XB_XSUB(j)  (1280 + 64 * (j))
#define XB_XGEN(j)  (2304 + 64 * (j))
#define XB_TOP      3328
#define XB_TOPGEN   3392
#define XCD_BAR_WORDS 3456
#define XB_SPIN_CAP (1u << 18)
#define LAS __attribute__((address_space(3)))

__device__ __forceinline__ unsigned xb_ld(unsigned* p)              { return __hip_atomic_load(p, __ATOMIC_RELAXED, __HIP_MEMORY_SCOPE_AGENT); }
__device__ __forceinline__ unsigned xb_add(unsigned* p, unsigned v) { return __hip_atomic_fetch_add(p, v, __ATOMIC_RELAXED, __HIP_MEMORY_SCOPE_AGENT); }
__device__ __forceinline__ unsigned xb_xcc_id() { return (unsigned)__builtin_amdgcn_s_getreg((3 << 11) | 20) & 0xFu; }
#define XB_SPIN(cond, bar) do { unsigned _sp = 0; while (cond) { __builtin_amdgcn_s_sleep(1); \
    if ((++_sp & 255u) == 0u) { if (xb_ld(&(bar)[XB_TMO])) break; if (_sp > XB_SPIN_CAP) { atomicAdd(&(bar)[XB_TMO], 1u); break; } } } } while (0)

struct XcdBarrier {
    unsigned* bar; unsigned x;
    volatile LAS unsigned* st;
};

__device__ __forceinline__ XcdBarrier xcd_barrier_post(unsigned* bar, volatile LAS unsigned* st) {
    XcdBarrier b; b.bar = bar; b.x = xb_xcc_id(); b.st = st;
    if (ltid() == 0) (void)xb_add(&bar[XB_XCNT(b.x)], 1u);
    return b;
}
__device__ __forceinline__ void xcd_barrier_complete(unsigned* bar, unsigned x, unsigned& nloc, unsigned& nx) {
    const unsigned G = lgdim() * gridDim.y * gridDim.z;
    unsigned sum, cnt, mine, sp = 0u;
    for (;;) {
        sum = 0u; cnt = 0u; mine = 0u;
#pragma unroll
        for (unsigned j = 0; j < 16; ++j) { const unsigned c = xb_ld(&bar[XB_XCNT(j)]); sum += c; cnt += (c > 0u) ? 1u : 0u; mine = (j == x) ? c : mine; }
        if (sum == G) break;
        __builtin_amdgcn_s_sleep(1);
        if ((++sp & 255u) == 0u) { if (xb_ld(&bar[XB_TMO])) break; if (sp > XB_SPIN_CAP) { atomicAdd(&bar[XB_TMO], 1u); break; } }
    }
    nloc = mine > 0u ? mine : 1u; nx = cnt > 0u ? cnt : 1u;
}

__device__ __forceinline__ void xcd_barrier(const XcdBarrier& b) {
    asm volatile("s_waitcnt vmcnt(0)" ::: "memory");
    __syncthreads();
    if (ltid() == 0) {
        unsigned* bar = b.bar;
        __builtin_amdgcn_s_waitcnt(0);
        unsigned nloc = b.st[0], nx = b.st[1];
        if (nloc == 0u) { xcd_barrier_complete(bar, b.x, nloc, nx); b.st[0] = nloc; b.st[1] = nx; }
        const unsigned old = xb_add(&bar[XB_XSUB(b.x)], 1u);
        const unsigned gen = old / nloc;
        if (old + 1u == (gen + 1u) * nloc) {
            __builtin_amdgcn_fence(__ATOMIC_RELEASE, "agent");
            asm volatile("s_waitcnt vmcnt(0)" ::: "memory");
            const unsigned og = xb_add(&bar[XB_TOP], 1u);
            const unsigned tg = og / nx;
            if (og + 1u == (tg + 1u) * nx) xb_add(&bar[XB_TOPGEN], 1u);
            else XB_SPIN(xb_ld(&bar[XB_TOPGEN]) == tg, bar);
            __builtin_amdgcn_fence(__ATOMIC_ACQUIRE, "agent");
            xb_add(&bar[XB_XGEN(b.x)], 1u);
            asm volatile("s_waitcnt vmcnt(0)" ::: "memory");
        } else {
            XB_SPIN(xb_ld(&bar[XB_XGEN(b.x)]) == gen, bar);
            __builtin_amdgcn_fence(__ATOMIC_ACQUIRE, "agent");
            asm volatile("s_waitcnt vmcnt(0)" ::: "memory");
        }
    }
    __syncthreads();
}


__global__ void __launch_bounds__(512, 2) mega(Params p_unused) {
    extern __shared__ __attribute__((aligned(16))) unsigned char lds[];
    typedef const __attribute__((address_space(4))) Params* KP;
    KP kp = (KP)__builtin_amdgcn_kernarg_segment_ptr();
    const int ph_lo = kp->ph_lo, ph_hi = kp->ph_hi;
    volatile LAS unsigned* const xst = (volatile LAS unsigned*)((LAS unsigned char*)lds + 151552);
    if (ltid() == 0) { xst[0] = 0u; xst[1] = 0u; }
    __syncthreads();
    if (ph_hi - ph_lo > 1) (void)xcd_barrier_post((unsigned*)(kp->ws + WS_BAR), xst);
    for (int ph = ph_lo; ph < ph_hi; ++ph) {
        asm volatile("" : "+s"(kp));
        const int tid = ltid(), wid = tid >> 6;
        unsigned char* const ws = kp->ws;
#define PIN(k) (kp->in[k])
        bf16_t* const w_abin = (bf16_t*)(ws + WS_ABIN); bf16_t* const w_about = (bf16_t*)(ws + WS_ABOUT); bf16_t* const w_cdin = (bf16_t*)(ws + WS_CDIN); bf16_t* const w_cdout = (bf16_t*)(ws + WS_CDOUT);
        bf16_t* const w_pool = (bf16_t*)(ws + WS_POOL); bf16_t* const w_gu = (bf16_t*)(ws + WS_GU); bf16_t* const w_down = (bf16_t*)(ws + WS_DOWN);
        bf16_t* const xb = (bf16_t*)(ws + WS_XB); float* const of = (float*)(ws + WS_XB); float* const ob = (float*)(ws + WS_OB);
        unsigned char* const R = ws + WS_R;
        bf16_t* const proj = (bf16_t*)R; bf16_t* const pooled = (bf16_t*)(R + R_POOLED); bf16_t* const mixout = (bf16_t*)(R + R_MIX);
        float* const y = (float*)R; bf16_t* const Hb = (bf16_t*)R; float* const y2 = (float*)(R + R_Y2);
#define XOUT (kp->out)
        const int L = (ph - 1) >> 3, s = (ph - 1) & 7, j = L >> 1; const bool isab = (L & 1) == 0;
        if (ph >= 1 && isab && s == 2) continue;
        int gk = -1; pg8::Gemm g{}; bf16_t* eo = nullptr; int eld = 0; const float* ecs = nullptr; float* ef = nullptr; int ea0 = 1 << 30, ea1 = 1 << 30, ea2 = 1 << 30;
        if (ph == 0) {
            float* tile = (float*)lds;
            { const int cb = lbid(), cn = lgdim();
              for (int q = 0; q < 2; ++q) {
                cvt_tr(PIN(1) + (size_t)q * DM * ABIN, DM, ABIN, w_abin + (size_t)q * ABIN * DM, DM, 0, tile, cb, cn);
                cvt_tr(PIN(2) + (size_t)q * DM * DM, DM, DM, w_about + (size_t)q * DM * DM, DM, 0, tile, cb, cn);
                cvt_tr(PIN(6) + (size_t)q * DM * CDIN, DM, CDIN, w_cdin + (size_t)q * CDIN * DM, DM, 0, tile, cb, cn);
                cvt_tr(PIN(7) + (size_t)q * DM * DM, DM, DM, w_cdout + (size_t)q * DM * DM, DM, 0, tile, cb, cn);
                for (int gi = 0; gi < 4; ++gi) cvt_tr(PIN(8) + (size_t)(q * 4 + gi) * 65536, 256, 256, w_pool + (size_t)(q * 4 + gi) * 65536, 256, 0, tile, cb, cn);
              }
              for (int l = 0; l < 4; ++l) {
                cvt_tr(PIN(14) + (size_t)l * DM * FFH, DM, FFH, w_gu + (size_t)l * 2 * FFH * DM, DM, 1, tile, cb, cn);
                cvt_tr(PIN(15) + (size_t)l * DM * FFH, DM, FFH, w_gu + (size_t)l * 2 * FFH * DM, DM, 2, tile, cb, cn);
                cvt_tr(PIN(16) + (size_t)l * FFH * DM, FFH, DM, w_down + (size_t)l * DM * FFH, FFH, 0, tile, cb, cn);
              } }
            const float* x = PIN(0);
            { const long xs = (long)lgdim() * 512;
              for (long i0 = (long)lbid() * 512 + tid; i0 < (long)MTOK * DM / 4; i0 += 4 * xs) { f32x4 v[4];
#pragma unroll
                for (int u = 0; u < 4; ++u) { const long i = i0 + u * xs; v[u] = (i < (long)MTOK * DM / 4) ? *(const f32x4*)(x + i * 4) : (f32x4){0.f, 0.f, 0.f, 0.f}; }
#pragma unroll
                for (int u = 0; u < 4; ++u) { const long i = i0 + u * xs; if (i < (long)MTOK * DM / 4) {
                    u32x2 w; w.x = pk2(v[u][0], v[u][1]); w.y = pk2(v[u][2], v[u][3]); *(u32x2*)(xb + i * 4) = w; } } } }
        } else if (s == 0) {
            if (isab) { g = pg8::Gemm{xb, w_abin + (size_t)j * ABIN * DM, MTOK, ABIN, DM, DM, 0}; eo = proj; eld = ABIN; ea0 = 12; ea1 = 16; ea2 = 24; }
            else      { g = pg8::Gemm{xb, w_cdin + (size_t)j * CDIN * DM, MTOK, CDIN, DM, DM, 0}; eo = proj; eld = CDIN; }
            gk = 0;
        } else if (s == 1) {
            if (isab) {
                const int G = lgdim(), nh = (G > 128) ? 128 : 0;
#ifndef NO_HGRN
                for (int item = lbid(); item < 128; item += G)
                    { const int hbh = (item & 7) | ((item >> 4) << 3), hdir = (item >> 3) & 1;
                      hgrn_dir(proj, PIN(4), j, hdir ? ob : of, hbh, hdir, (PG8_LAS unsigned char*)lds, of, ob, PIN(5) + j * 1024, mixout, (unsigned*)(ws + WS_BAR + 14336) + j * 64); }
#endif
#ifndef NO_NA
                if (lbid() >= nh) na_mfma(proj, PIN(3) + (size_t)j * 8 * 465, mixout, lbid() - nh, G - nh, (PG8_LAS unsigned char*)lds);
#endif
            } else {
#ifndef NO_PREP
                cd_prep(proj, PIN(10) + j * 128, PIN(11) + j * 128, pooled);
#endif
            }
        } else if (s == 2) {
            if (!isab) {
#ifndef NO_ATT
                for (int u = lbid(); u < 512; u += lgdim()) {
                    const int qb = u & 7, h = (u >> 3) & 7, b = u >> 6;
                    const bf16_t* qp = proj + (size_t)(b * SEQ + qb * 256) * CDIN + 1024 + h * 128;
                    const bf16_t* kp = proj + (size_t)(b * SEQ) * CDIN + 2048 + (h >> 2) * 128;
                    att::attn_dense_body<att::bf16>((const att::bf16*)qp, (const att::bf16*)kp, (const att::bf16*)(kp + 256), mixout + (size_t)(b * SEQ + qb * 256) * DM + 1024 + h * 128, SEQ, (char*)lds);
                    __syncthreads();
                }
#endif
                g = pg8::Gemm{pooled, w_pool + (size_t)j * 4 * 65536, MTOK, 1024, 256, 1024, 512}; eo = mixout; eld = DM; ecs = PIN(9) + j * 1024; gk = 4;
            }
        } else if (s == 3) {
            g = pg8::Gemm{mixout, (isab ? w_about : w_cdout) + (size_t)j * DM * DM, MTOK, DM, DM, DM, 0}; ef = y; gk = 1;
        } else if (s == 4) {
            ln_phase(XOUT, xb, PIN(12) + L * DM, PIN(13) + L * DM, (float*)(ws + WS_XCH), false);
        } else if (s == 5) {
            g = pg8::Gemm{xb, w_gu + (size_t)L * 2 * FFH * DM, MTOK, 2 * FFH, DM, DM, 0}; gk = 2;
        } else if (s == 6) {
            g = pg8::Gemm{Hb, w_down + (size_t)L * DM * FFH, MTOK, DM, FFH, FFH, 0}; ef = y2; gk = 3;
        } else {
            ln_phase(XOUT, xb, PIN(17) + L * DM, PIN(18) + L * DM, (float*)(ws + WS_XCH), L == 3);
        }
        if (gk >= 0) {
            pg8::StaticOrder S; S.init(g.M, g.N, lgdim(), lbid());
            PG8_LAS unsigned char* l3 = (PG8_LAS unsigned char*)lds;
            if (gk == 0) { pg8::EpiBf16S E{eo, eld, nullptr, ea0, ea1, ea2}; pg8::gemm_phase<pg8::EpiBf16S, pg8::StaticOrder, true, true, 2048, 2048, 0>(l3, g, S, E); }
            else if (gk == 1) { pg8::EpiF32 E{XOUT, (L == 0) ? PIN(0) : (const float*)XOUT, DM, DN_ALPHA, (L == 0) ? nullptr : (const float*)(ws + WS_XCH), PIN(17) + (L - 1) * DM, PIN(18) + (L - 1) * DM}; pg8::gemm_phase<pg8::EpiF32, pg8::StaticOrder, true, true, 2048, 2048, 0>(l3, g, S, E); }
            else if (gk == 2) { pg8::EpiSwiGLU E{Hb, FFH}; pg8::gemm_phase<pg8::EpiSwiGLU, pg8::StaticOrder, true, true, 2048, 2048, 0>(l3, g, S, E); }
            else if (gk == 3) { pg8::EpiF32 E{XOUT, (const float*)XOUT, DM, DN_ALPHA, (const float*)(ws + WS_XCH), PIN(12) + L * DM, PIN(13) + L * DM}; pg8::gemm_phase<pg8::EpiF32, pg8::StaticOrder, true, true, 5632, 5632, 0>(l3, g, S, E); }
            else { pg8::EpiBf16S E{eo, eld, ecs, 1 << 30, 1 << 30, 1 << 30}; pg8::gemm_phase<pg8::EpiBf16S, pg8::StaticOrder, true, true, 256, 1024, 512>(l3, g, S, E); }
        }
        if (ph + 1 < ph_hi) {
            if (ph == 0) cg::this_grid().sync();
            else { XcdBarrier xb; xb.bar = (unsigned*)(kp->ws + WS_BAR); xb.x = xb_xcc_id(); xb.st = xst; xcd_barrier(xb); } }
    }
}

extern "C" void kernel_launch(void* const* d_in, const int* in_sizes, int n_in, void* d_out, int out_size, void* d_ws, size_t ws_size, hipStream_t stream) {
    static int grid = 0;
    if (grid == 0) {
        if (n_in != 19 || out_size != MTOK * DM || ws_size < WS_TOTAL) { fprintf(stderr, "kernel_launch: unexpected shapes n_in %d out %d ws %zu (need %zu)\n", n_in, out_size, ws_size, (size_t)WS_END); grid = -1; return; }
        int dev = 0, cus = 0, per_cu = 0;
        hipGetDevice(&dev); hipDeviceGetAttribute(&cus, hipDeviceAttributeMultiprocessorCount, dev);
        if (hipFuncSetAttribute((const void*)mega, hipFuncAttributeMaxDynamicSharedMemorySize, LDS_BYTES) != hipSuccess) { fprintf(stderr, "kernel_launch: hipFuncSetAttribute failed\n"); grid = -1; return; }
        if (hipOccupancyMaxActiveBlocksPerMultiprocessor(&per_cu, (const void*)mega, 512, LDS_BYTES) != hipSuccess || per_cu < 1) { fprintf(stderr, "kernel_launch: occupancy query gave %d\n", per_cu); per_cu = 1; }
        (void)hipGetLastError();
        grid = cus * 1;
    }
    if (grid < 0) return;
    Params p{};
    for (int i = 0; i < 19; ++i) p.in[i] = (const float*)d_in[i];
    p.out = (float*)d_out; p.ws = (unsigned char*)d_ws;
#if MK_SINGLE
    if (hipMemsetAsync((char*)d_ws + WS_BAR, 0, 16384, stream) != hipSuccess) { fprintf(stderr, "kernel_launch: memset of the barrier words failed\n"); return; }
    p.ph_lo = 0; p.ph_hi = NPH;
    void* args[] = {&p};
    hipError_t e = hipLaunchCooperativeKernel((const void*)mega, dim3(grid), dim3(512), args, LDS_BYTES, stream);
    if (e != hipSuccess) fprintf(stderr, "cooperative launch failed: %s (grid %d)\n", hipGetErrorString(e), grid);
#else
    for (int ph = 0; ph < NPH; ++ph) {
        if (ph >= 1) { const int L = (ph - 1) >> 3, s = (ph - 1) & 7; if (s == 2 && (L & 1) == 0) continue; }
        p.ph_lo = ph; p.ph_hi = ph + 1;
        hipLaunchKernelGGL(mega, dim3(grid), dim3(512), LDS_BYTES, stream, p);
    }
#endif
}
```

```cpp
#include <hip/hip_runtime.h>
#include <hip/hip_bf16.h>
#include <hip/hip_cooperative_groups.h>
#include <cstdio>
#include <cstdint>
namespace cg = cooperative_groups;
__device__ __forceinline__ int ltid() { int t = __builtin_amdgcn_workitem_id_x(); asm volatile("" : "+v"(t)); return t; }
__device__ __forceinline__ int lbid() { int t = __builtin_amdgcn_workgroup_id_x(); asm volatile("" : "+s"(t)); return t; }
__device__ __forceinline__ int lgdim() { int t = (int)__ockl_get_num_groups(0); asm volatile("" : "+s"(t)); return t; }

#ifndef MK_SINGLE
#define MK_SINGLE 1
#endif

namespace pg8 {
#define PG8_LAS __attribute__((address_space(3)))
typedef unsigned short bf16_t;
typedef short bf16x8 __attribute__((ext_vector_type(8)));
typedef float f32x4 __attribute__((ext_vector_type(4)));
typedef unsigned u32x4 __attribute__((ext_vector_type(4)));
constexpr int BM = 256, BK = 64, HALF = 128, HTB = HALF * BK * 2  , STAGE_BYTES = 8 * HTB, NXCD = 8, WGM = 4;

__host__ __device__ __forceinline__ int lds_byte(int r, int c) { const int st = (r >> 4) * 2 + (c >> 5), rr = r & 15, cc = c & 31, ob = rr * 64 + cc * 2; return st * 1024 + (ob ^ (((ob >> 9) & 1) << 5)); }
__host__ __device__ __forceinline__ void stage_rc(int b, int& R, int& C) { const int st = b / 1024, sb = b % 1024, swz = sb ^ (((sb >> 9) & 1) << 5); R = (st >> 1) * 16 + swz / 64; C = (st & 1) * 32 + (swz % 64) / 2; }
__host__ __device__ __forceinline__ int perm32(int rho) { const int n = rho >> 4, i = rho & 15; return 8 * (i >> 2) + 4 * n + (i & 3); }

struct Unit { int pm, pn; };
struct Gemm { const bf16_t* A; const bf16_t* Bt; int M, N, K, lda; long apn; };

struct StaticOrder {
    int nM, nN, nwg, G, c;
    __host__ __device__ void init(int M, int N, int G_, int c_) { nM = M / BM; nN = N / BM; nwg = nM * nN; G = G_; c = c_; }
    __host__ __device__ bool next(int i, Unit& u) const {
        const long L = (long)i * G + c; if (L >= nwg) return false;
        int wgid = (int)L; { const int q = nwg / NXCD, r = nwg % NXCD, xcd = wgid % NXCD, off = wgid / NXCD; wgid = (xcd < r ? xcd * (q + 1) : r * (q + 1) + (xcd - r) * q) + off; }
        const int nig = WGM * nN, gid = wgid / nig, fm = gid * WGM, gsz = (nM - fm) < WGM ? (nM - fm) : WGM;
        u.pm = fm + ((wgid % nig) % gsz); u.pn = (wgid % nig) / gsz; return true;
    }
    __device__ __forceinline__ void a_ready(const Unit&) const {}
    __device__ __forceinline__ void done(const Unit&) const {}
};

__device__ __forceinline__ unsigned cvt_pk_bf16(float lo, float hi) { unsigned r; asm volatile("v_cvt_pk_bf16_f32 %0, %1, %2" : "=v"(r) : "v"(lo), "v"(hi)); return r; }
typedef float f32x2 __attribute__((ext_vector_type(2)));

struct EpiBf16S {
    static constexpr bool PERM = true, AFTER_DRAIN = false;
    bf16_t* O; int ldc; const float* cs; int a0, a1, a2;
    __device__ __forceinline__ void operator()(const f32x4 (&acc)[2][2][4][2], const Unit& u, int wr, int wc, int fr, int fq) const {
        const int row0 = u.pm * BM + wr * 64 + fr, col0 = u.pn * BM + wc * 32 + 8 * fq;
        const int act = (u.pn >= a0 && u.pn < a1) ? 1 : ((u.pn >= a1 && u.pn < a2) ? 2 : 0);
        f32x4 sv[2][2];
#pragma unroll
        for (int bj = 0; bj < 2; ++bj)
#pragma unroll
            for (int n = 0; n < 2; ++n) sv[bj][n] = cs ? *(const f32x4*)(cs + col0 + bj * HALF + 4 * n) : (f32x4){1.f, 1.f, 1.f, 1.f};
#pragma unroll
        for (int ai = 0; ai < 2; ++ai)
#pragma unroll
            for (int m = 0; m < 4; ++m) { bf16_t* rowp = O + (size_t)(row0 + ai * HALF + m * 16) * ldc + col0;
#pragma unroll
                for (int bj = 0; bj < 2; ++bj) { f32x4 v0 = acc[ai][bj][m][0] * sv[bj][0], v1 = acc[ai][bj][m][1] * sv[bj][1];
                    if (act) {
#pragma unroll
                        for (int e = 0; e < 4; ++e) { const float s0 = __builtin_amdgcn_rcpf(1.0f + __builtin_amdgcn_exp2f(-1.4426950408889634f * v0[e])), s1 = __builtin_amdgcn_rcpf(1.0f + __builtin_amdgcn_exp2f(-1.4426950408889634f * v1[e]));
                            v0[e] = (act == 1) ? v0[e] * s0 : s0; v1[e] = (act == 1) ? v1[e] * s1 : s1; } }
                    u32x4 w; w.x = cvt_pk_bf16(v0[0], v0[1]); w.y = cvt_pk_bf16(v0[2], v0[3]); w.z = cvt_pk_bf16(v1[0], v1[1]); w.w = cvt_pk_bf16(v1[2], v1[3]);
                    *(u32x4*)(rowp + bj * HALF) = w; } }
    }
};
struct EpiF32 {
    static constexpr bool PERM = false, AFTER_DRAIN = false;
    float* O; const float* R; int ldc; float alpha; const float* st; const float* g; const float* b;
    __device__ __forceinline__ void operator()(const f32x4 (&acc)[2][2][4][2], const Unit& u, int wr, int wc, int fr, int fq) const {
        const int row0 = u.pm * BM + wr * 64 + fr, col0 = u.pn * BM + wc * 32 + 4 * fq;
        f32x4 gv[2][2], bv[2][2];
#pragma unroll
        for (int bj = 0; bj < 2; ++bj)
#pragma unroll
            for (int n = 0; n < 2; ++n) { gv[bj][n] = st ? *(const f32x4*)(g + col0 + bj * HALF + n * 16) : (f32x4){1.f, 1.f, 1.f, 1.f}; bv[bj][n] = st ? *(const f32x4*)(b + col0 + bj * HALF + n * 16) : (f32x4){0.f, 0.f, 0.f, 0.f}; }
#pragma unroll
        for (int ai = 0; ai < 2; ++ai)
#pragma unroll
            for (int m = 0; m < 4; ++m) { const int row = row0 + ai * HALF + m * 16; float* rowp = O + (size_t)row * ldc + col0; const float* rsrc = R + (size_t)row * ldc + col0;
                float mean = 0.f, rstd = 1.f; if (st) { mean = st[2 * row]; rstd = st[2 * row + 1]; }
                f32x4 xr[2][2];
#pragma unroll
                for (int bj = 0; bj < 2; ++bj)
#pragma unroll
                    for (int n = 0; n < 2; ++n) xr[bj][n] = *(const f32x4*)(rsrc + bj * HALF + n * 16);
#pragma unroll
                for (int bj = 0; bj < 2; ++bj)
#pragma unroll
                    for (int n = 0; n < 2; ++n) { const f32x4 xn = (xr[bj][n] - mean) * rstd * gv[bj][n] + bv[bj][n]; *(f32x4*)(rowp + bj * HALF + n * 16) = acc[ai][bj][m][n] + xn * alpha; }
                asm volatile("" ::: "memory"); }
    }
};
struct EpiSwiGLU {
    static constexpr bool PERM = true, AFTER_DRAIN = false;
    bf16_t* Hh; int ldh;
    __device__ __forceinline__ void operator()(const f32x4 (&acc)[2][2][4][2], const Unit& u, int wr, int wc, int fr, int fq) const {
        const int row0 = u.pm * BM + wr * 64 + fr, col0 = u.pn * HALF + wc * 32 + 8 * fq;
#pragma unroll
        for (int ai = 0; ai < 2; ++ai)
#pragma unroll
            for (int m = 0; m < 4; ++m) { bf16_t* rowp = Hh + (size_t)(row0 + ai * HALF + m * 16) * ldh + col0;
                float h[8];
#pragma unroll
                for (int n = 0; n < 2; ++n)
#pragma unroll
                    for (int e = 0; e < 4; ++e) { const float g = acc[ai][0][m][n][e], up = acc[ai][1][m][n][e];
                        const float sg = __builtin_amdgcn_rcpf(1.0f + __builtin_amdgcn_exp2f(-1.4426950408889634f * g));
                        h[n * 4 + e] = g * sg * up; }
                u32x4 w; w.x = cvt_pk_bf16(h[0], h[1]); w.y = cvt_pk_bf16(h[2], h[3]); w.z = cvt_pk_bf16(h[4], h[5]); w.w = cvt_pk_bf16(h[6], h[7]);
                *(u32x4*)rowp = w; }
    }
};
template <class Epi, class Sched, bool ALIGN_EPI, bool SP2, int KC, int LDA, int APN>
__device__ __forceinline__ void gemm_phase(PG8_LAS unsigned char* lds, const Gemm g, const Sched& S, const Epi& E) {
    const int tid = ltid(), wid = __builtin_amdgcn_readfirstlane(tid >> 6), lane = tid & 63, wr = wid >> 2, wc = wid & 3, fr = lane & 15, fq = lane >> 4;
    constexpr int K = KC, nt = K / BK;
    unsigned voffA[2], voffB[2];
#pragma unroll
    for (int i = 0; i < 2; ++i) { int R, C; stage_rc(tid * 16 + i * 8192, R, C); const int Rb = Epi::PERM ? ((R & ~31) + perm32(R & 31)) : R;
        voffA[i] = (unsigned)(R * LDA + C) * 2u; voffB[i] = (unsigned)(Rb * K + C) * 2u; }
    const size_t kstep = (size_t)(BK * 2);
    const size_t hstepB = (size_t)HALF * K * 2, hstepA = (size_t)HALF * LDA * 2;
    const size_t tstepB = 2 * hstepB, tstepA = 2 * hstepA;
    const unsigned ldsw = (unsigned)wid * 1024u;
    const int aoff = lds_byte(wr * 64 + fr, fq * 8), boff = lds_byte(wc * 32 + fr, fq * 8);
#define PG8_SA(b, h) (((b) * 2 + (h)) * HTB)
#define PG8_SB(b, h) ((4 + (b) * 2 + (h)) * HTB)
#define PG8_STAGE(bufoff, gbase, voff) do { const char* _gb = (const char*)(gbase); asm volatile("" : "+s"(_gb)); _Pragma("unroll") for (int _i = 0; _i < 2; ++_i) \
        __builtin_amdgcn_global_load_lds((const unsigned*)(_gb + (voff)[_i]), (PG8_LAS unsigned*)(lds + (bufoff) + ldsw + _i * 8192), 16, 0, 0); } while (0)
#define PG8_LDA(dst, b, h) do { _Pragma("unroll") for (int m = 0; m < 4; ++m) _Pragma("unroll") for (int k = 0; k < 2; ++k) dst[m][k] = *(const PG8_LAS bf16x8*)(lds + PG8_SA(b, h) + aoff + m * 2048 + k * 1024); } while (0)
#define PG8_LDB(dst, b, h) do { _Pragma("unroll") for (int n = 0; n < 2; ++n) _Pragma("unroll") for (int k = 0; k < 2; ++k) dst[n][k] = *(const PG8_LAS bf16x8*)(lds + PG8_SB(b, h) + boff + n * 2048 + k * 1024); } while (0)
#define PG8_MMA(ai, bj, At, Bt) do { __builtin_amdgcn_s_setprio(1); _Pragma("unroll") for (int m = 0; m < 4; ++m) _Pragma("unroll") for (int n = 0; n < 2; ++n) _Pragma("unroll") for (int k = 0; k < 2; ++k) \
        acc[ai][bj][m][n] = __builtin_amdgcn_mfma_f32_16x16x32_bf16(Bt[n][k], At[m][k], acc[ai][bj][m][n], 0, 0, 0); __builtin_amdgcn_s_setprio(0); } while (0)
#define PG8_WAIT_V(n) asm volatile("s_waitcnt vmcnt(" #n ")" ::: "memory")
#define PG8_WAIT_L(n) asm volatile("s_waitcnt lgkmcnt(" #n ")" ::: "memory")
#define PG8_BAR __builtin_amdgcn_s_barrier()
#define PG8_SCHED __builtin_amdgcn_sched_barrier(0)
    Unit cur, nxt; int ui = 0;
    if (!S.next(0, cur)) return;
    f32x4 acc[2][2][4][2];
#pragma unroll
    for (int a = 0; a < 2; ++a)
#pragma unroll
        for (int b = 0; b < 2; ++b)
#pragma unroll
            for (int m = 0; m < 4; ++m)
#pragma unroll
                for (int n = 0; n < 2; ++n) acc[a][b][m][n] = (f32x4){0.f, 0.f, 0.f, 0.f};
    bf16x8 At[4][2], B0[2][2], B1[2][2];
    const char* cA = (const char*)g.A + (size_t)cur.pm * tstepA + (size_t)cur.pn * APN; const char* cB = (const char*)g.Bt + (size_t)cur.pn * tstepB;
    S.a_ready(cur);
    if constexpr (SP2) {
        PG8_STAGE(PG8_SB(0, 0), cB, voffB); PG8_STAGE(PG8_SB(0, 1), cB + hstepB, voffB); PG8_STAGE(PG8_SA(0, 0), cA, voffA); PG8_STAGE(PG8_SA(0, 1), cA + hstepA, voffA);
        if (wr == 1) PG8_BAR;
        PG8_WAIT_V(2); PG8_BAR;
        PG8_STAGE(PG8_SB(1, 0), cB + kstep, voffB); PG8_STAGE(PG8_SA(1, 0), cA + kstep, voffA); PG8_STAGE(PG8_SB(1, 1), cB + hstepB + kstep, voffB);
        PG8_WAIT_V(6); PG8_BAR;
    } else {
        PG8_STAGE(PG8_SB(0, 0), cB, voffB); PG8_STAGE(PG8_SA(0, 0), cA, voffA); PG8_STAGE(PG8_SB(0, 1), cB + hstepB, voffB); PG8_STAGE(PG8_SA(0, 1), cA + hstepA, voffA);
        if (wr == 1) PG8_BAR;
        PG8_WAIT_V(4); PG8_BAR;
        PG8_STAGE(PG8_SB(1, 0), cB + kstep, voffB); PG8_STAGE(PG8_SA(1, 0), cA + kstep, voffA); PG8_STAGE(PG8_SB(1, 1), cB + hstepB + kstep, voffB);
        PG8_WAIT_V(6); PG8_BAR;
    }
    for (;;) {
        const bool has_next = S.next(ui + 1, nxt);
        const char* nA = has_next ? (const char*)g.A + (size_t)nxt.pm * tstepA + (size_t)nxt.pn * APN : cA; const char* nB = has_next ? (const char*)g.Bt + (size_t)nxt.pn * tstepB : cB;
        for (int t = 0; t < nt; t += 2) {
            const bool last = (t == nt - 2);
            const char* a1 = cA + (size_t)(t + 1) * kstep;
            const char* a2 = last ? nA : cA + (size_t)(t + 2) * kstep; const char* b2 = last ? nB : cB + (size_t)(t + 2) * kstep;
            const char* a3 = a2 + kstep; const char* b3 = b2 + kstep;
            if (last && has_next) S.a_ready(nxt);
            if constexpr (SP2) {
            PG8_LDB(B0, 0, 0); PG8_LDB(B1, 0, 1); PG8_SCHED; PG8_LDA(At, 0, 0); PG8_STAGE(PG8_SA(1, 1), a1 + hstepA, voffA);
            PG8_WAIT_V(8); PG8_WAIT_L(0); PG8_BAR; PG8_MMA(0, 0, At, B0); PG8_MMA(0, 1, At, B1); PG8_BAR; PG8_SCHED;
            PG8_LDA(At, 0, 1); PG8_STAGE(PG8_SB(0, 0), b2, voffB); PG8_STAGE(PG8_SB(0, 1), b2 + hstepB, voffB); PG8_STAGE(PG8_SA(0, 0), a2, voffA);
            PG8_WAIT_V(8); PG8_WAIT_L(0); PG8_BAR; PG8_MMA(1, 0, At, B0); PG8_MMA(1, 1, At, B1); PG8_BAR; PG8_SCHED;
            PG8_LDB(B0, 1, 0); PG8_LDB(B1, 1, 1); PG8_SCHED; PG8_LDA(At, 1, 0); PG8_STAGE(PG8_SA(0, 1), a2 + hstepA, voffA);
            PG8_WAIT_V(8); PG8_WAIT_L(0); PG8_BAR; PG8_MMA(0, 0, At, B0); PG8_MMA(0, 1, At, B1); PG8_BAR; PG8_SCHED;
            PG8_LDA(At, 1, 1); PG8_STAGE(PG8_SB(1, 0), b3, voffB); PG8_STAGE(PG8_SB(1, 1), b3 + hstepB, voffB); PG8_STAGE(PG8_SA(1, 0), a3, voffA);
            PG8_WAIT_V(8); PG8_WAIT_L(0); PG8_BAR; PG8_MMA(1, 0, At, B0); PG8_MMA(1, 1, At, B1); PG8_BAR; PG8_SCHED;
            } else {
            PG8_LDB(B0, 0, 0); PG8_SCHED; PG8_LDA(At, 0, 0); PG8_STAGE(PG8_SA(1, 1), a1 + hstepA, voffA);
            PG8_WAIT_L(8); PG8_BAR; PG8_WAIT_L(0); PG8_MMA(0, 0, At, B0); PG8_BAR; PG8_SCHED;
            PG8_LDB(B1, 0, 1); PG8_STAGE(PG8_SB(0, 0), b2, voffB);
            PG8_BAR; PG8_WAIT_L(0); PG8_MMA(0, 1, At, B1); PG8_BAR;
            PG8_LDA(At, 0, 1); PG8_STAGE(PG8_SA(0, 0), a2, voffA);
            PG8_BAR; PG8_WAIT_L(0); PG8_MMA(1, 0, At, B0); PG8_BAR; PG8_SCHED;
            PG8_STAGE(PG8_SB(0, 1), b2 + hstepB, voffB);
            PG8_WAIT_V(6); PG8_BAR; PG8_MMA(1, 1, At, B1); PG8_BAR;
            PG8_LDB(B0, 1, 0); PG8_SCHED; PG8_LDA(At, 1, 0); PG8_STAGE(PG8_SA(0, 1), a2 + hstepA, voffA);
            PG8_WAIT_L(8); PG8_BAR; PG8_WAIT_L(0); PG8_MMA(0, 0, At, B0); PG8_BAR; PG8_SCHED;
            PG8_LDB(B1, 1, 1); PG8_STAGE(PG8_SB(1, 0), b3, voffB);
            PG8_BAR; PG8_WAIT_L(0); PG8_MMA(0, 1, At, B1); PG8_BAR;
            PG8_LDA(At, 1, 1); PG8_STAGE(PG8_SA(1, 0), a3, voffA);
            PG8_BAR; PG8_WAIT_L(0); PG8_MMA(1, 0, At, B0); PG8_BAR; PG8_SCHED;
            PG8_STAGE(PG8_SB(1, 1), b3 + hstepB, voffB);
            PG8_WAIT_V(6); PG8_BAR; PG8_MMA(1, 1, At, B1); PG8_BAR;
            }
        }
        if constexpr (ALIGN_EPI) { if (wr == 0) PG8_BAR; }
        if constexpr (!Epi::AFTER_DRAIN) { E(acc, cur, wr, wc, fr, fq); S.done(cur); }
        if (!has_next) break;
#pragma unroll
        for (int a = 0; a < 2; ++a)
#pragma unroll
            for (int b = 0; b < 2; ++b)
#pragma unroll
                for (int m = 0; m < 4; ++m)
#pragma unroll
                    for (int n = 0; n < 2; ++n) acc[a][b][m][n] = (f32x4){0.f, 0.f, 0.f, 0.f};
        cur = nxt; cA = nA; cB = nB; ++ui;
        if constexpr (ALIGN_EPI) { if (wr == 1) PG8_BAR; }
    }
    PG8_WAIT_V(0);
    if constexpr (!ALIGN_EPI) { if (wr == 0) PG8_BAR; }
    PG8_BAR;
    if constexpr (Epi::AFTER_DRAIN) { E.fused(acc, cur, wr, wc, fr, fq, lds, wid, lane); S.done(cur); }
#undef PG8_SA
#undef PG8_SB
#undef PG8_STAGE
#undef PG8_LDA
#undef PG8_LDB
#undef PG8_MMA
#undef PG8_WAIT_V
#undef PG8_WAIT_L
#undef PG8_BAR
#undef PG8_SCHED
}
}


namespace att {
using bf16 = __hip_bfloat16;
constexpr int D = 128, NW = 8, QBLK = 32, KVBLK = 64;
constexpr float SCALE = 0.088388347648318440f;
constexpr float THR = 8.f;
constexpr int SDEPTH = 2;
constexpr int LDQ = 2560, LDK = 2560, LDO = 2048;
constexpr size_t SHM_V = KVBLK * D * 2, SHM_K = KVBLK * D * 2, SHM_ATTN = 2 * SHM_V + 2 * SHM_K + NW * 64 * 4;
using bf16x8 = __attribute__((ext_vector_type(8))) short;
using s16x4  = __attribute__((ext_vector_type(4))) short;
using f32x16 = __attribute__((ext_vector_type(16))) float;
using f32x8  = __attribute__((ext_vector_type(8))) float;
using u32x4  = __attribute__((ext_vector_type(4))) unsigned;
#define KSWZ(row, colB) ((row) * 256 + ((colB) ^ (((row) & 7) << 4)))
#define SBAR() __builtin_amdgcn_sched_barrier(0)
__device__ __forceinline__ int crow(int r, int hi) { return (r & 3) + 8 * (r >> 2) + 4 * hi; }
__device__ __forceinline__ unsigned cvtpk(float lo, float hi) {
  unsigned r; asm volatile("v_cvt_pk_bf16_f32 %0, %1, %2" : "=v"(r) : "v"(lo), "v"(hi)); return r;
}
template <typename TIn> struct Stage;
template <> struct Stage<bf16>  { using T = bf16x8;
  __device__ static __forceinline__ T ld8(const bf16* p) { return *reinterpret_cast<const bf16x8*>(p); }
  __device__ static __forceinline__ bf16x8 tobf(T x) { return x; } };
template <> struct Stage<float> { using T = f32x8;
  __device__ static __forceinline__ T ld8(const float* p) { return *reinterpret_cast<const f32x8*>(p); }
  __device__ static __forceinline__ bf16x8 tobf(T x) {
    u32x4 w = {cvtpk(x[0], x[1]), cvtpk(x[2], x[3]), cvtpk(x[4], x[5]), cvtpk(x[6], x[7])}; return *reinterpret_cast<bf16x8*>(&w); } };

__device__ __forceinline__ void partialSM(f32x16& p0, f32x16& p1, float& m_reg, float& mn, float& alpha) {
  constexpr float C = SCALE * 1.4426950408889634f;
  float pmax = p0[0]; for (int r = 1; r < 16; ++r) pmax = fmaxf(pmax, p0[r]); for (int r = 0; r < 16; ++r) pmax = fmaxf(pmax, p1[r]);
  { auto rr = __builtin_amdgcn_permlane32_swap(__float_as_uint(pmax), __float_as_uint(pmax), false, false);
    pmax = fmaxf(__uint_as_float(rr[0]), __uint_as_float(rr[1])); }
  if (__builtin_expect(__all(pmax - m_reg <= THR / SCALE), 1)) { mn = m_reg; alpha = 1.f; }
  else { mn = fmaxf(m_reg, pmax); alpha = __builtin_amdgcn_exp2f((m_reg - mn) * C); m_reg = mn; }
  float mnC = -mn * C;
  for (int r = 0; r < 16; ++r) p0[r] = fmaf(p0[r], C, mnC); for (int r = 0; r < 16; ++r) p1[r] = fmaf(p1[r], C, mnC);
  for (int r = 0; r < 16; ++r) p0[r] = __builtin_amdgcn_exp2f(p0[r]);
}
__device__ __forceinline__ void finishSM(f32x16& p0, f32x16& p1, float alpha, float& l_reg, bf16x8& pa0, bf16x8& pa1, bf16x8& pa2, bf16x8& pa3) {
  for (int r = 0; r < 16; ++r) p1[r] = __builtin_amdgcn_exp2f(p1[r]);
  float ps = 0; for (int r = 0; r < 16; ++r) ps += p0[r]; for (int r = 0; r < 16; ++r) ps += p1[r];
  { auto rr = __builtin_amdgcn_permlane32_swap(__float_as_uint(ps), __float_as_uint(ps), false, false);
    ps = __uint_as_float(rr[0]) + __uint_as_float(rr[1]); }
  l_reg = l_reg * alpha + ps;
#define PK4(P, BASE, OUT) do { unsigned a0 = cvtpk(P[BASE + 0], P[BASE + 1]), a1 = cvtpk(P[BASE + 2], P[BASE + 3]);   \
    unsigned b0 = cvtpk(P[BASE + 4], P[BASE + 5]), b1 = cvtpk(P[BASE + 6], P[BASE + 7]);                              \
    auto r0 = __builtin_amdgcn_permlane32_swap(a0, b0, false, false); auto r1 = __builtin_amdgcn_permlane32_swap(a1, b1, false, false); \
    u32x4 w = {r0[0], r1[0], r0[1], r1[1]}; OUT = *reinterpret_cast<bf16x8*>(&w); } while (0)
  PK4(p0, 0, pa0); PK4(p0, 8, pa1); PK4(p1, 0, pa2); PK4(p1, 8, pa3);
#undef PK4
}
__device__ __forceinline__ void qkt(f32x16& p0, f32x16& p1, const bf16* Ks, const bf16x8* qr, int r32, int hi) {
  p0 = f32x16{}; p1 = f32x16{};
  for (int d0 = 0; d0 < 8; ++d0) { int cb = (d0 * 16 + hi * 8) * 2;
    bf16x8 b0 = *reinterpret_cast<const bf16x8*>((const char*)Ks + KSWZ(r32, cb));
    bf16x8 b1 = *reinterpret_cast<const bf16x8*>((const char*)Ks + KSWZ(32 + r32, cb));
    p0 = __builtin_amdgcn_mfma_f32_32x32x16_bf16(b0, qr[d0], p0, 0, 0, 0);
    p1 = __builtin_amdgcn_mfma_f32_32x32x16_bf16(b1, qr[d0], p1, 0, 0, 0); }
}
__device__ __forceinline__ int v_st(int k, int c) { const int kk = (k & ~0xC) | ((k & 4) << 1) | ((k & 8) >> 1); return ((kk >> 3) * 4 + (c >> 5)) * 512 + ((kk & 7) * 32 + (c & 31)) * 2; }
__device__ __forceinline__ int v_rd_base(int lane) { return ((lane & 3) << 3) | (((lane >> 2) & 3) << 6) | (((lane >> 4) & 1) << 5) | (((lane >> 5) & 1) << 8); }
constexpr int v_rd_off(int d0, int ks, int half) { return d0 * 512 + ks * 4096 + half * 2048; }
template <int OFF> __device__ __forceinline__ s16x4 tr_read(int vb) {
  s16x4 r; asm volatile("ds_read_b64_tr_b16 %0, %1 offset:%2" : "=&v"(r) : "v"(vb), "i"(OFF) : "memory"); return r;
}
template <int D0> __device__ __forceinline__ void pv_one(f32x16& od, int vb, bf16x8 pa0, bf16x8 pa1, bf16x8 pa2, bf16x8 pa3) {
  const s16x4 l0 = tr_read<v_rd_off(D0, 0, 0)>(vb), h0 = tr_read<v_rd_off(D0, 0, 1)>(vb), l1 = tr_read<v_rd_off(D0, 1, 0)>(vb), h1 = tr_read<v_rd_off(D0, 1, 1)>(vb);
  const s16x4 l2 = tr_read<v_rd_off(D0, 2, 0)>(vb), h2 = tr_read<v_rd_off(D0, 2, 1)>(vb), l3 = tr_read<v_rd_off(D0, 3, 0)>(vb), h3 = tr_read<v_rd_off(D0, 3, 1)>(vb);
  asm volatile("s_waitcnt lgkmcnt(0)" ::: "memory"); SBAR();
#define PK(L, H) (bf16x8){L[0], L[1], L[2], L[3], H[0], H[1], H[2], H[3]}
  od = __builtin_amdgcn_mfma_f32_32x32x16_bf16(pa0, PK(l0, h0), od, 0, 0, 0);
  od = __builtin_amdgcn_mfma_f32_32x32x16_bf16(pa1, PK(l1, h1), od, 0, 0, 0);
  od = __builtin_amdgcn_mfma_f32_32x32x16_bf16(pa2, PK(l2, h2), od, 0, 0, 0);
  od = __builtin_amdgcn_mfma_f32_32x32x16_bf16(pa3, PK(l3, h3), od, 0, 0, 0);
#undef PK
}
__device__ __forceinline__ void pv_d0(f32x16* o, int vb, bf16x8 pa0, bf16x8 pa1, bf16x8 pa2, bf16x8 pa3) {
  pv_one<0>(o[0], vb, pa0, pa1, pa2, pa3); pv_one<1>(o[1], vb, pa0, pa1, pa2, pa3); pv_one<2>(o[2], vb, pa0, pa1, pa2, pa3); pv_one<3>(o[3], vb, pa0, pa1, pa2, pa3);
}


template <typename TQ>
__device__ __forceinline__ void attn_dense_body(const TQ* __restrict__ Qb, const bf16* __restrict__ Kh, const bf16* __restrict__ Vh,
                                                unsigned short* __restrict__ Ob, int seq, char* lds) {
  using St = Stage<bf16>; using SQ = Stage<TQ>;
  const int tid = ltid(), wid = tid >> 6, lane = tid & 63, r32 = lane & 31, hi = lane >> 5;
  bf16* V_lds = (bf16*)lds; bf16* K_lds = (bf16*)(lds + 2 * SHM_V);
  float* ws = (float*)(lds + 2 * SHM_V + 2 * SHM_K) + wid * 64; float* li_l = ws; float* al_l = ws + 32;
  float m_reg = -1e30f, l_reg = 0; f32x16 o[4] = {}; bf16x8 qr[8];
  const TQ* Qw = Qb + (long)(wid * QBLK + r32) * LDQ + hi * 8;
#pragma unroll
  for (int d0 = 0; d0 < 8; ++d0) qr[d0] = SQ::tobf(SQ::ld8(Qw + d0 * 16));
  const int sr = tid >> 4, sc = (tid & 15) * 8, vst0 = v_st(sr, sc), vst1 = v_st(32 + sr, sc);
  const int vb0 = (int)(uintptr_t)V_lds + v_rd_base(lane);
  struct { typename St::T vs0, vs1, ks0, ks1; } sr_[SDEPTH];
#define SLOAD(i, k0) do { sr_[i].vs0 = St::ld8(&Vh[(long)((k0) + sr) * LDK + sc]); sr_[i].vs1 = St::ld8(&Vh[(long)((k0) + 32 + sr) * LDK + sc]); \
    sr_[i].ks0 = St::ld8(&Kh[(long)((k0) + sr) * LDK + sc]); sr_[i].ks1 = St::ld8(&Kh[(long)((k0) + 32 + sr) * LDK + sc]); } while (0)
#define SWRITE(b, i) do { *(bf16x8*)((char*)V_lds + (b) * SHM_V + vst0) = St::tobf(sr_[i].vs0);          \
    *(bf16x8*)((char*)V_lds + (b) * SHM_V + vst1) = St::tobf(sr_[i].vs1); int kc = sc * 2;               \
    *(bf16x8*)((char*)K_lds + (b) * SHM_K + KSWZ(sr, kc)) = St::tobf(sr_[i].ks0);                       \
    *(bf16x8*)((char*)K_lds + (b) * SHM_K + KSWZ(32 + sr, kc)) = St::tobf(sr_[i].ks1); } while (0)
#define SWAIT() do { if constexpr (SDEPTH == 2) asm volatile("s_waitcnt vmcnt(4)" ::: "memory"); else asm volatile("s_waitcnt vmcnt(0)" ::: "memory"); } while (0)
#define RESC(a) do { if (__any((a) < 1.f)) { if (hi == 0) al_l[r32] = (a); asm volatile("s_waitcnt lgkmcnt(0)" ::: "memory"); \
    for (int d = 0; d < 4; ++d) for (int r = 0; r < 16; ++r) o[d][r] *= al_l[crow(r, hi)]; } } while (0)
  f32x16 pA0, pA1, pB0, pB1; float mnA, mnB, alA, alB; bf16x8 pa0, pa1, pa2, pa3; const int NT = seq / KVBLK;
  constexpr int SE = 0, SO = SDEPTH - 1;
  SLOAD(SE, 0); asm volatile("s_waitcnt vmcnt(0)" ::: "memory"); SWRITE(0, SE); __syncthreads();
  qkt(pA0, pA1, K_lds, qr, r32, hi); partialSM(pA0, pA1, m_reg, mnA, alA);
  SLOAD(SO, KVBLK); if constexpr (SDEPTH == 2) { if (2 < NT) SLOAD(SE, 2 * KVBLK); }
  SWAIT(); SWRITE(1, SO); __syncthreads();
  for (int j = 1; j + 1 < NT; j += 2) {
    SBAR(); qkt(pB0, pB1, (bf16*)((char*)K_lds + SHM_K), qr, r32, hi);
    finishSM(pA0, pA1, alA, l_reg, pa0, pa1, pa2, pa3); SBAR();
    SLOAD(SO, (j + SDEPTH) * KVBLK); SBAR();
    pv_d0(o, vb0, pa0, pa1, pa2, pa3); partialSM(pB0, pB1, m_reg, mnB, alB);
    __syncthreads(); SWAIT(); SWRITE(0, SE);
    RESC(alB); __syncthreads();
    SBAR(); qkt(pA0, pA1, K_lds, qr, r32, hi);
    finishSM(pB0, pB1, alB, l_reg, pa0, pa1, pa2, pa3); SBAR();
    if (SDEPTH == 1 || j + 3 < NT) SLOAD(SE, (j + 1 + SDEPTH) * KVBLK); SBAR();
    pv_d0(o, vb0 + (int)SHM_V, pa0, pa1, pa2, pa3); partialSM(pA0, pA1, m_reg, mnA, alA);
    __syncthreads(); SWAIT(); SWRITE(1, SO);
    RESC(alA); __syncthreads();
  }
  SBAR(); qkt(pB0, pB1, (bf16*)((char*)K_lds + SHM_K), qr, r32, hi);
  finishSM(pA0, pA1, alA, l_reg, pa0, pa1, pa2, pa3); SBAR();
  pv_d0(o, vb0, pa0, pa1, pa2, pa3); partialSM(pB0, pB1, m_reg, mnB, alB);
  __syncthreads(); RESC(alB);
  finishSM(pB0, pB1, alB, l_reg, pa0, pa1, pa2, pa3); SBAR();
  pv_d0(o, vb0 + (int)SHM_V, pa0, pa1, pa2, pa3);
  if (hi == 0) li_l[r32] = l_reg; asm volatile("s_waitcnt lgkmcnt(0)" ::: "memory");
  float rli[16];
#pragma unroll
  for (int r = 0; r < 16; ++r) rli[r] = __builtin_amdgcn_rcpf(li_l[crow(r, hi)]);
  unsigned short* Ow = Ob + (long)(wid * QBLK) * LDO;
#pragma unroll
  for (int r = 0; r < 16; ++r) { int orow = crow(r, hi);
    for (int d0 = 0; d0 < 4; ++d0) { const float ov = o[d0][r] * rli[r]; Ow[(long)orow * LDO + d0 * 32 + r32] = (unsigned short)cvtpk(ov, ov); } }
#undef SLOAD
#undef SWRITE
#undef SWAIT
#undef RESC
}


}

typedef unsigned short bf16_t;
typedef float f32x4 __attribute__((ext_vector_type(4)));
typedef unsigned u32x4 __attribute__((ext_vector_type(4)));
typedef unsigned u32x2 __attribute__((ext_vector_type(2)));
constexpr int MTOK = 16384, DM = 2048, ABIN = 8192, CDIN = 2560, FFH = 5632, SEQ = 2048;
constexpr int NPH = 33;
constexpr float DN_ALPHA = 1.6817928305074290f;
constexpr size_t WS_ABIN = 0;
constexpr size_t WS_ABOUT = WS_ABIN + 2ull * ABIN * DM * 2;
constexpr size_t WS_CDIN = WS_ABOUT + 2ull * DM * DM * 2;
constexpr size_t WS_CDOUT = WS_CDIN + 2ull * CDIN * DM * 2;
constexpr size_t WS_POOL = WS_CDOUT + 2ull * DM * DM * 2;
constexpr size_t WS_GU = WS_POOL + 2ull * 4 * 256 * 256 * 2;
constexpr size_t WS_DOWN = WS_GU + 4ull * 2 * FFH * DM * 2;
constexpr size_t WS_XB = WS_DOWN + 4ull * DM * FFH * 2;
constexpr size_t WS_R = WS_XB + (size_t)MTOK * DM * 2;
constexpr size_t R_POOLED = (size_t)MTOK * CDIN * 2;
constexpr size_t R_MIX = (size_t)MTOK * ABIN * 2;
constexpr size_t R_Y2 = (size_t)MTOK * FFH * 2;
constexpr size_t WS_END = WS_R + R_MIX + (size_t)MTOK * DM * 2;
constexpr size_t WS_BAR = WS_END; constexpr size_t WS_OB = WS_BAR + 16384; constexpr size_t WS_XCH = WS_OB + (size_t)MTOK * 1024 * 4;
constexpr size_t WS_TOTAL = WS_XCH + (size_t)MTOK * 2 * 4;
constexpr int LDS_BYTES = 151552 + 16;

struct Params { const float* in[19]; float* out; unsigned char* ws; int ph_lo, ph_hi; };

__device__ __forceinline__ float bflo(unsigned w) { return __uint_as_float(w << 16); }
__device__ __forceinline__ float bfhi(unsigned w) { return __uint_as_float(w & 0xffff0000u); }
__device__ __forceinline__ unsigned pk2(float lo, float hi) { return pg8::cvt_pk_bf16(lo, hi); }
typedef float f32x2c_t __attribute__((ext_vector_type(2))); typedef __bf16 bf16x2c_t __attribute__((ext_vector_type(2)));
__device__ __forceinline__ unsigned pk2s(float lo, float hi) { f32x2c_t v = {lo, hi}; bf16x2c_t b = __builtin_convertvector(v, bf16x2c_t); return __builtin_bit_cast(unsigned, b); }
__device__ __forceinline__ float sigmoidf_(float z) { return 1.0f / (1.0f + __expf(-z)); }
template <int M> __device__ __forceinline__ float swz_xor(float v) { return __int_as_float(__builtin_amdgcn_ds_swizzle(__float_as_int(v), (M << 10) | 0x1f)); }
__device__ __forceinline__ float sum32(float v) { auto r = __builtin_amdgcn_permlane32_swap(__float_as_uint(v), __float_as_uint(v), false, false); return __uint_as_float(r[0]) + __uint_as_float(r[1]); }
__device__ __forceinline__ float max32(float v) { auto r = __builtin_amdgcn_permlane32_swap(__float_as_uint(v), __float_as_uint(v), false, false); return fmaxf(__uint_as_float(r[0]), __uint_as_float(r[1])); }
__device__ __forceinline__ float sum_lo32(float v) { v += swz_xor<16>(v); v += swz_xor<8>(v); v += swz_xor<4>(v); v += swz_xor<2>(v); v += swz_xor<1>(v); return v; }
__device__ __forceinline__ float wave_sum(float v) { return sum_lo32(sum32(v)); }
__device__ __forceinline__ float wave_max(float v) { v = max32(v); v = fmaxf(v, swz_xor<16>(v)); v = fmaxf(v, swz_xor<8>(v)); v = fmaxf(v, swz_xor<4>(v)); v = fmaxf(v, swz_xor<2>(v)); v = fmaxf(v, swz_xor<1>(v)); return v; }
#define LDS_FENCE() asm volatile("s_waitcnt lgkmcnt(0)" ::: "memory")

__device__ __forceinline__ void cvt_tr(const float* __restrict__ src, int K, int N, bf16_t* __restrict__ dst, int ldd, int mode, float* tile, int bid, int nb) {
    const int tid = ltid(), tn = N >> 6, nt = tn * (K >> 7);
    const int kr0 = tid >> 4, nc = (tid & 15) * 4;
    f32x4 r[4];
    if (bid < nt) { const int kt = bid / tn, k0 = kt * 128, n0 = (bid - kt * tn) * 64;
#pragma unroll
        for (int i = 0; i < 4; ++i) r[i] = *(const f32x4*)(src + (size_t)(k0 + kr0 + 32 * i) * N + n0 + nc); }
    for (int t = bid; t < nt; t += nb) {
        const int kt = t / tn, k0 = kt * 128, n0 = (t - kt * tn) * 64;
#pragma unroll
        for (int i = 0; i < 4; ++i) { float* tp = tile + (kr0 + 32 * i) * 65 + nc; tp[0] = r[i][0]; tp[1] = r[i][1]; tp[2] = r[i][2]; tp[3] = r[i][3]; }
        __syncthreads();
        if (t + nb < nt) { const int t2 = t + nb, kt2 = t2 / tn, k2 = kt2 * 128, n2 = (t2 - kt2 * tn) * 64;
#pragma unroll
            for (int i = 0; i < 4; ++i) r[i] = *(const f32x4*)(src + (size_t)(k2 + kr0 + 32 * i) * N + n2 + nc); }
        const int nr = tid >> 3, kc = (tid & 7) * 16;
        float v[16];
#pragma unroll
        for (int i = 0; i < 16; ++i) v[i] = tile[(kc + i) * 65 + nr];
        const int n = n0 + nr; const int drow = mode == 0 ? n : ((n >> 7) * 256 + (n & 127) + (mode == 2 ? 128 : 0));
        u32x4 w0, w1; w0.x = pk2(v[0], v[1]); w0.y = pk2(v[2], v[3]); w0.z = pk2(v[4], v[5]); w0.w = pk2(v[6], v[7]);
        w1.x = pk2(v[8], v[9]); w1.y = pk2(v[10], v[11]); w1.z = pk2(v[12], v[13]); w1.w = pk2(v[14], v[15]);
        bf16_t* dp = dst + (size_t)drow * ldd + k0 + kc; *(u32x4*)dp = w0; *(u32x4*)(dp + 8) = w1;
        __syncthreads();
    }
}

__device__ __forceinline__ void ln_phase(float* __restrict__ X, bf16_t* __restrict__ xb, const float* __restrict__ g, const float* __restrict__ b, float* __restrict__ st, bool writeX) {
    const int lane = ltid() & 63, wid = ltid() >> 6;
    for (int row = (lbid() * 8 + wid) * 4; row < MTOK; row += lgdim() * 32) {
        const size_t ro = (size_t)row * DM;
        f32x4 v[4][8]; float s[4] = {0.f, 0.f, 0.f, 0.f};
#pragma unroll
        for (int rr = 0; rr < 4; ++rr)
#pragma unroll
            for (int i = 0; i < 8; ++i) { const int c = (i * 64 + lane) * 4; v[rr][i] = *(const f32x4*)(X + ro + rr * DM + c); }
#pragma unroll
        for (int rr = 0; rr < 4; ++rr)
#pragma unroll
            for (int i = 0; i < 8; ++i) s[rr] += (v[rr][i][0] + v[rr][i][1]) + (v[rr][i][2] + v[rr][i][3]);
        float rstd[4];
#pragma unroll
        for (int rr = 0; rr < 4; ++rr) { const float mean = wave_sum(s[rr]) * (1.0f / DM); float q = 0.f;
#pragma unroll
            for (int i = 0; i < 8; ++i) { v[rr][i] = v[rr][i] - mean; q += (v[rr][i][0] * v[rr][i][0] + v[rr][i][1] * v[rr][i][1]) + (v[rr][i][2] * v[rr][i][2] + v[rr][i][3] * v[rr][i][3]); }
            rstd[rr] = rsqrtf(wave_sum(q) * (1.0f / DM) + 1e-5f);
            if (lane == 0) { st[2 * (row + rr)] = mean; st[2 * (row + rr) + 1] = rstd[rr]; } }
#pragma unroll
        for (int i = 0; i < 8; ++i) { const int c = (i * 64 + lane) * 4; const f32x4 gv = *(const f32x4*)(g + c), bv = *(const f32x4*)(b + c);
#pragma unroll
            for (int rr = 0; rr < 4; ++rr) { const f32x4 o = v[rr][i] * rstd[rr] * gv + bv; if (writeX) *(f32x4*)(X + ro + rr * DM + c) = o;
                u32x2 w; w.x = pk2(o[0], o[1]); w.y = pk2(o[2], o[3]); *(u32x2*)(xb + ro + rr * DM + c) = w; } }
    }
}

typedef short s16x8 __attribute__((ext_vector_type(8)));
typedef float f32x2g __attribute__((ext_vector_type(2)));
#define MFMA16(a, b, c) __builtin_amdgcn_mfma_f32_16x16x32_bf16(a, b, c, 0, 0, 0)
__device__ __forceinline__ s16x8 mk8(unsigned a, unsigned b, unsigned c, unsigned d) { u32x4 w = {a, b, c, d}; return *reinterpret_cast<s16x8*>(&w); }
__device__ __forceinline__ float clamp80(float x) { return fminf(fmaxf(x, -80.f), 80.f); }
constexpr int HD_TOT_OFF = 72704;
__device__ __forceinline__ void hgrn_dir(const bf16_t* __restrict__ proj, const float* __restrict__ lbl, int jl, float* __restrict__ odir, int bh, int dir, __attribute__((address_space(3))) unsigned char* lds) {
    typedef __attribute__((address_space(3))) unsigned char* L3p; typedef __attribute__((address_space(3))) bf16_t* L3h; typedef __attribute__((address_space(3))) float* L3f;
    typedef __attribute__((address_space(3))) u32x4* L3q;
    const int tid = ltid(), wv = __builtin_amdgcn_readfirstlane(tid >> 6), lane0 = tid & 63;
    const int b = bh >> 3, h = bh & 7;
    const L3p L = (L3p)lds;
    const L3f eRv = (L3f)L; const L3f eLv = eRv + 128;
    const L3h Qd = (L3h)(L + 1024); const L3h Kd = (L3h)(L + 18432); const L3h Pm = (L3h)(L + HD_TOT_OFF + 4096); const L3h KdT = (L3h)(L + 35840); const L3h VT = (L3h)(L + 54272);
    const L3f tot = (L3f)(L + HD_TOT_OFF);
    float lb0 = 0.f, lb1 = 0.f;
    if (jl != 0) { const int ch = h * 128 + 2 * lane0; const f32x2g l0 = *(const f32x2g*)(lbl + ch), l1 = *(const f32x2g*)(lbl + 1024 + ch);
        { const float mx = fmaxf(l0.x, l1.x), e0 = __expf(l0.x - mx), e1 = __expf(l1.x - mx); lb0 = e1 / (e0 + e1); }
        { const float mx = fmaxf(l0.y, l1.y), e0 = __expf(l0.y - mx), e1 = __expf(l1.y - mx); lb1 = e1 / (e0 + e1); } }
    const float om0 = 1.f - lb0, om1 = 1.f - lb1;
    const size_t tok0 = (size_t)b * SEQ;
    const bf16_t* pbase = proj + h * 128 + 2 * lane0;
    const int zoff = dir ? 5120 : 4096;
    unsigned zr[8], qr[8], vr[8];
    f32x4 S[8];
#pragma unroll
    for (int i = 0; i < 8; ++i) S[i] = (f32x4){0.f, 0.f, 0.f, 0.f};
#define HD_T(k_, tau_) (dir ? ((31 - (k_)) * 64 + 63 - (tau_)) : ((k_) * 64 + (tau_)))
#define HD_LOAD(k_) do { _Pragma("unroll") for (int i = 0; i < 8; ++i) { const bf16_t* rp = pbase + (tok0 + HD_T(k_, 8 * wv + i)) * ABIN; \
        zr[i] = *(const unsigned*)(rp + zoff); qr[i] = *(const unsigned*)(rp + 3072); vr[i] = *(const unsigned*)(rp + 6144); } } while (0)
    HD_LOAD(0);
    for (int k = 0; k < 32; ++k) {
        int lane = lane0; asm volatile("" : "+v"(lane)); const int fr = lane & 15, fq = lane >> 4;
        float g0[8], g1[8]; unsigned kpk[8]; float T0 = 0.f, T1 = 0.f;
#pragma unroll
        for (int i = 0; i < 8; ++i) { const float s0 = bflo(zr[i]), s1 = bfhi(zr[i]);
            T0 += __logf(lb0 + om0 * s0); T1 += __logf(lb1 + om1 * s1); g0[i] = T0; g1[i] = T1; kpk[i] = pk2(om0 * (1.f - s0), om1 * (1.f - s1)); }
        *(__attribute__((address_space(3))) f32x2g*)(tot + wv * 128 + 2 * lane) = (f32x2g){T0, T1};
        __syncthreads();
        { float p0 = 0.f, p1 = 0.f, R0 = 0.f, R1 = 0.f, GL0 = 0.f, GL1 = 0.f;
#pragma unroll
          for (int q = 0; q < 8; ++q) { const f32x2g tq_ = *(const __attribute__((address_space(3))) f32x2g*)(tot + q * 128 + 2 * lane);
              if (q < wv) { p0 += tq_.x; p1 += tq_.y; } if (q < 4) { R0 += tq_.x; R1 += tq_.y; } GL0 += tq_.x; GL1 += tq_.y; }
          const float eLR0 = __expf(clamp80(GL0 - R0)), eLR1 = __expf(clamp80(GL1 - R1));
          if (wv == 0) { *(__attribute__((address_space(3))) f32x2g*)(eRv + 2 * lane) = (f32x2g){__expf(R0), __expf(R1)}; *(__attribute__((address_space(3))) f32x2g*)(eLv + 2 * lane) = (f32x2g){__expf(GL0), __expf(GL1)}; }
          unsigned kt0[4], kt1[4], vt0[4], vt1[4];
#pragma unroll
          for (int i = 0; i < 8; i += 2) { float kk0[2], kk1[2];
#pragma unroll
              for (int e = 0; e < 2; ++e) { const int ii = i + e;
                  const float E0 = __expf(clamp80(p0 + g0[ii] - R0)), E1 = __expf(clamp80(p1 + g1[ii] - R1));
                  const float qs0 = bflo(qr[ii]), qs1 = bfhi(qr[ii]);
                  const float kd0 = bflo(kpk[ii]) * __builtin_amdgcn_rcpf(E0), kd1 = bfhi(kpk[ii]) * __builtin_amdgcn_rcpf(E1);
                  *(__attribute__((address_space(3))) unsigned*)(Qd + (8 * wv + ii) * 136 + 2 * lane) = pk2(qs0 * E0, qs1 * E1);
                  *(__attribute__((address_space(3))) unsigned*)(Kd + (8 * wv + ii) * 136 + 2 * lane) = pk2(kd0, kd1);
                  kk0[e] = kd0 * eLR0; kk1[e] = kd1 * eLR1; }
              kt0[i >> 1] = pk2(kk0[0], kk0[1]); kt1[i >> 1] = pk2(kk1[0], kk1[1]);
              vt0[i >> 1] = (vr[i] & 0xffffu) | (vr[i + 1] << 16); vt1[i >> 1] = (vr[i] >> 16) | (vr[i + 1] & 0xffff0000u); }
          const L3h kp0 = KdT + (2 * lane) * 72 + 8 * wv; const L3h vp0 = VT + (2 * lane) * 72 + 8 * wv;
          *(L3q)kp0 = (u32x4){kt0[0], kt0[1], kt0[2], kt0[3]}; *(L3q)(kp0 + 72) = (u32x4){kt1[0], kt1[1], kt1[2], kt1[3]};
          *(L3q)vp0 = (u32x4){vt0[0], vt0[1], vt0[2], vt0[3]}; *(L3q)(vp0 + 72) = (u32x4){vt1[0], vt1[1], vt1[2], vt1[3]}; }
        if (k + 1 < 32) HD_LOAD(k + 1);
        __syncthreads();
        const int tb_ = wv & 3, sb0 = 2 * (wv >> 2);
        unsigned pw[2][2];
        { s16x8 qf[4];
#pragma unroll
          for (int ks = 0; ks < 4; ++ks) qf[ks] = *(const __attribute__((address_space(3))) s16x8*)(Qd + (16 * tb_ + fr) * 136 + 32 * ks + 8 * fq);
#pragma unroll
          for (int si = 0; si < 2; ++si) { const int sb = sb0 + si; f32x4 a = {0.f, 0.f, 0.f, 0.f};
              if (sb <= tb_) {
#pragma unroll
                  for (int ks = 0; ks < 4; ++ks) { const s16x8 kf = *(const __attribute__((address_space(3))) s16x8*)(Kd + (16 * sb + fr) * 136 + 32 * ks + 8 * fq); a = MFMA16(kf, qf[ks], a); }
                  if (sb == tb_) {
#pragma unroll
                      for (int r = 0; r < 4; ++r) if (4 * fq + r > fr) a[r] = 0.f; } }
              pw[si][0] = pk2s(a[0], a[1]); pw[si][1] = pk2s(a[2], a[3]); } }
#pragma unroll
        for (int si = 0; si < 2; ++si) *(__attribute__((address_space(3))) u32x2*)(Pm + (16 * tb_ + fr) * 72 + 16 * (sb0 + si) + 4 * fq) = (u32x2){pw[si][0], pw[si][1]};
        f32x4 oacc[4];
#pragma unroll
        for (int tb = 0; tb < 4; ++tb) oacc[tb] = (f32x4){0.f, 0.f, 0.f, 0.f};
#pragma unroll
        for (int ks = 0; ks < 4; ++ks) {
            const f32x4 ea = *(const __attribute__((address_space(3))) f32x4*)(eRv + 32 * ks + 4 * fq), eb = *(const __attribute__((address_space(3))) f32x4*)(eRv + 32 * ks + 16 + 4 * fq);
            const f32x4 a = S[2 * ks] * ea, c = S[2 * ks + 1] * eb; const s16x8 xf = mk8(pk2(a[0], a[1]), pk2(a[2], a[3]), pk2(c[0], c[1]), pk2(c[2], c[3]));
#pragma unroll
            for (int tb = 0; tb < 4; ++tb) { const u32x2 qa = *(const __attribute__((address_space(3))) u32x2*)(Qd + (16 * tb + fr) * 136 + 32 * ks + 4 * fq), qb = *(const __attribute__((address_space(3))) u32x2*)(Qd + (16 * tb + fr) * 136 + 32 * ks + 16 + 4 * fq);
                oacc[tb] = MFMA16(xf, mk8(qa.x, qa.y, qb.x, qb.y), oacc[tb]); } }
        __syncthreads();
        s16x8 vf[2];
#pragma unroll
        for (int ks2 = 0; ks2 < 2; ++ks2) vf[ks2] = *(const __attribute__((address_space(3))) s16x8*)(VT + (16 * wv + fr) * 72 + 32 * ks2 + 8 * fq);
#pragma unroll
        for (int tb = 0; tb < 4; ++tb)
#pragma unroll
            for (int ks2 = 0; ks2 < 2; ++ks2) if (ks2 <= (tb >> 1)) { const s16x8 pf = *(const __attribute__((address_space(3))) s16x8*)(Pm + (16 * tb + fr) * 72 + 32 * ks2 + 8 * fq);
                oacc[tb] = MFMA16(vf[ks2], pf, oacc[tb]); }
#pragma unroll
        for (int tb = 0; tb < 4; ++tb) { const size_t token = tok0 + HD_T(k, 16 * tb + fr); *(f32x4*)(odir + token * 1024 + h * 128 + 16 * wv + 4 * fq) = oacc[tb]; }
#pragma unroll
        for (int blk = 0; blk < 8; ++blk) { const f32x4 el = *(const __attribute__((address_space(3))) f32x4*)(eLv + 16 * blk + 4 * fq);
            S[blk] = S[blk] * el;
#pragma unroll
            for (int ks2 = 0; ks2 < 2; ++ks2) { const s16x8 kf = *(const __attribute__((address_space(3))) s16x8*)(KdT + (16 * blk + fr) * 72 + 32 * ks2 + 8 * fq); S[blk] = MFMA16(kf, vf[ks2], S[blk]); } }
    }
    __syncthreads();
#undef HD_T
#undef HD_LOAD
}
__device__ __forceinline__ void hgrn_combine(const float* __restrict__ of, const float* __restrict__ ob, const bf16_t* __restrict__ proj, const float* __restrict__ normw, bf16_t* __restrict__ mixout) {
    const long stride = (long)lgdim() * 512;
    for (long it0 = (long)lbid() * 512 + ltid(); it0 < (long)MTOK * 256; it0 += 4 * stride) {
        f32x4 o[4]; u32x2 gw[4];
#pragma unroll
        for (int u = 0; u < 4; ++u) { const long it = it0 + u * stride; if (it < (long)MTOK * 256) { const size_t token = (size_t)(it >> 8); const int col = (int)(it & 255) * 4;
            o[u] = *(const f32x4*)(of + token * 1024 + col) + *(const f32x4*)(ob + token * 1024 + col); gw[u] = *(const u32x2*)(proj + token * ABIN + 7168 + col); } else { o[u] = (f32x4){0.f, 0.f, 0.f, 0.f}; gw[u] = (u32x2){0u, 0u}; } }
#pragma unroll
        for (int u = 0; u < 4; ++u) { const long it = it0 + u * stride; const size_t token = (size_t)(it >> 8); const int col = (int)(it & 255) * 4;
            float ss = (o[u][0] * o[u][0] + o[u][1] * o[u][1]) + (o[u][2] * o[u][2] + o[u][3] * o[u][3]);
            ss = sum_lo32(ss);
            const float rs = rsqrtf(ss * (1.0f / 128.0f) + 1e-6f);
            const f32x4 nw = *(const f32x4*)(normw + col);
            const float gg[4] = {bflo(gw[u].x), bfhi(gw[u].x), bflo(gw[u].y), bfhi(gw[u].y)}; float r[4];
#pragma unroll
            for (int i = 0; i < 4; ++i) r[i] = o[u][i] * rs * nw[i] * gg[i] * __builtin_amdgcn_rcpf(1.f + __expf(-gg[i]));
            if (it < (long)MTOK * 256) *(u32x2*)(mixout + token * DM + 1024 + col) = (u32x2){pk2(r[0], r[1]), pk2(r[2], r[3])}; }
    }
}

constexpr int NA_VT_BYTES = 2 * 128 * 72 * 2;
constexpr int NA_RPB_OFF = 2 * NA_VT_BYTES;
__device__ __forceinline__ void na_mfma(const bf16_t* __restrict__ proj, const float* __restrict__ rpb, bf16_t* __restrict__ mixout, int unit0, int ustride, __attribute__((address_space(3))) unsigned char* lds) {
    typedef __attribute__((address_space(3))) unsigned char* L3p; typedef __attribute__((address_space(3))) bf16_t* L3h; typedef __attribute__((address_space(3))) float* L3f;
    const int tid = ltid(), wv = __builtin_amdgcn_readfirstlane(tid >> 6), hd = wv >> 2, g = wv & 3, lane = tid & 63, fr = lane & 15, fq = lane >> 4;
    const L3f rl = (L3f)(lds + NA_RPB_OFF);
    for (int i = tid; i < 8 * 465; i += 512) rl[i] = rpb[i];
    const int cw = (g == 0) ? 0 : (g == 1) ? 8 : (g == 2) ? 24 : 32;
    const int c = 16 * g + fr, cs = min(max(c - 8, 0), 48);
    const int skp = tid & 31, spart = tid >> 5, shead = spart >> 3, sd0 = (spart & 7) * 16;
    __syncthreads();
    for (int unit = unit0; unit < 1024; unit += ustride) {
        const int hp = unit & 3, r = (unit >> 2) & 31, b = unit >> 7, h = hp * 2 + hd, r0 = min(max(r - 4, 0), 24);
        const size_t tokq = (size_t)b * SEQ + r * 64 + c;
        s16x8 qf[4];
#pragma unroll
        for (int ks = 0; ks < 4; ++ks) qf[ks] = *(const s16x8*)(proj + tokq * ABIN + h * 128 + 32 * ks + 8 * fq);
        const bf16_t* vsrc = proj + ((size_t)b * SEQ + r0 * 64 + 2 * skp) * ABIN + 2048 + (hp * 2 + shead) * 128 + sd0;
        u32x4 vreg[2][4];
#pragma unroll
        for (int q = 0; q < 4; ++q) { vreg[0][q] = *(const u32x4*)(vsrc + (size_t)(q >> 1) * ABIN + 8 * (q & 1)); vreg[1][q] = *(const u32x4*)(vsrc + (size_t)(64 + (q >> 1)) * ABIN + 8 * (q & 1)); }
        f32x4 sc[8][2];
        const bf16_t* kbase = proj + ((size_t)b * SEQ + r0 * 64 + cw + 8 * (fr >> 2) + (fr & 3)) * ABIN + 1024 + h * 128 + 8 * fq;
#pragma unroll
        for (int j = 0; j < 8; ++j)
#pragma unroll
            for (int hf = 0; hf < 2; ++hf) { f32x4 a = {0.f, 0.f, 0.f, 0.f};
#pragma unroll
                for (int ks = 0; ks < 4; ++ks) { const s16x8 kf = *(const s16x8*)(kbase + (size_t)(j * 64 + 4 * hf) * ABIN + 32 * ks); a = MFMA16(kf, qf[ks], a); }
                sc[j][hf] = a; }
        float mx = -3.0e38f;
#pragma unroll
        for (int j = 0; j < 8; ++j) { const int ro = h * 465 + (r0 + j - r + 7) * 31 + 15 - c;
#pragma unroll
            for (int hf = 0; hf < 2; ++hf)
#pragma unroll
                for (int e = 0; e < 4; ++e) { const int kc = cw + 8 * fq + 4 * hf + e; const bool ok = (kc >= cs) && (kc < cs + 16);
                    const float bias = rl[ok ? (ro + kc) : 0];
                    const float s = ok ? (sc[j][hf][e] * 0.088388347648318440f + bias) : -3.0e38f; sc[j][hf][e] = s; mx = fmaxf(mx, s); } }
        mx = fmaxf(mx, swz_xor<16>(mx)); mx = max32(mx);
        float sum = 0.f; s16x8 pf[8];
#pragma unroll
        for (int j = 0; j < 8; ++j) { float p[8];
#pragma unroll
            for (int hf = 0; hf < 2; ++hf)
#pragma unroll
                for (int e = 0; e < 4; ++e) { const float pv = __expf(sc[j][hf][e] - mx); p[hf * 4 + e] = pv; sum += pv; }
            pf[j] = mk8(pk2(p[0], p[1]), pk2(p[2], p[3]), pk2(p[4], p[5]), pk2(p[6], p[7])); }
        sum += swz_xor<16>(sum); sum = sum32(sum);
        const float inv = 1.0f / sum;
        f32x4 oacc[8];
#pragma unroll
        for (int db = 0; db < 8; ++db) oacc[db] = (f32x4){0.f, 0.f, 0.f, 0.f};
#pragma unroll
        for (int j = 0; j < 8; ++j) {
            const L3h vt = (L3h)(lds + (j & 1) * NA_VT_BYTES) + shead * (128 * 72) + sd0 * 72 + 2 * skp;
#pragma unroll
            for (int hh = 0; hh < 2; ++hh) { const unsigned a[4] = {vreg[j & 1][hh].x, vreg[j & 1][hh].y, vreg[j & 1][hh].z, vreg[j & 1][hh].w}, c[4] = {vreg[j & 1][2 + hh].x, vreg[j & 1][2 + hh].y, vreg[j & 1][2 + hh].z, vreg[j & 1][2 + hh].w};
#pragma unroll
                for (int e = 0; e < 4; ++e) { *(__attribute__((address_space(3))) unsigned*)(vt + (8 * hh + 2 * e) * 72) = (a[e] & 0xffffu) | (c[e] << 16);
                    *(__attribute__((address_space(3))) unsigned*)(vt + (8 * hh + 2 * e + 1) * 72) = (a[e] >> 16) | (c[e] & 0xffff0000u); } }
            __syncthreads();
            if (j + 2 < 8) {
#pragma unroll
                for (int q = 0; q < 4; ++q) vreg[j & 1][q] = *(const u32x4*)(vsrc + (size_t)((j + 2) * 64 + (q >> 1)) * ABIN + 8 * (q & 1)); }
            const L3h vr = (L3h)(lds + (j & 1) * NA_VT_BYTES) + hd * (128 * 72) + fr * 72 + cw + 8 * fq;
#pragma unroll
            for (int db = 0; db < 8; ++db) oacc[db] = MFMA16(*(const __attribute__((address_space(3))) s16x8*)(vr + db * 16 * 72), pf[j], oacc[db]);
        }
        bf16_t* op = mixout + tokq * DM + h * 128 + 4 * fq;
#pragma unroll
        for (int db = 0; db < 8; ++db) { const f32x4 o = oacc[db] * inv; *(u32x2*)(op + 16 * db) = (u32x2){pk2(o[0], o[1]), pk2(o[2], o[3])}; }
        __syncthreads();
    }
}

__device__ __forceinline__ void cd_prep(bf16_t* __restrict__ proj, const float* __restrict__ qn, const float* __restrict__ kn, bf16_t* __restrict__ pooled) {
    const int tid = ltid(), lane = tid & 63, wid = tid >> 6;
    const int nw = lgdim() * 8, w0 = lbid() * 8 + wid;
    { const int f = lane & 31; const float inv = exp2f(-(float)f * (13.287712379549449f / 32.0f));
      for (int it0 = w0; it0 < MTOK * 10; it0 += 4 * nw) {
        unsigned w[4];
#pragma unroll
        for (int u = 0; u < 4; ++u) { const int it = it0 + u * nw; const int token = it / 10, hh = it - token * 10;
            w[u] = (it < MTOK * 10) ? *(const unsigned*)(proj + (size_t)token * CDIN + 1024 + hh * 128 + 2 * lane) : 0u; }
#pragma unroll
        for (int u = 0; u < 4; ++u) { const int it = it0 + u * nw; const int token = it / 10, hh = it - token * 10, t = token & 2047;
            const float x0 = bflo(w[u]), x1 = bfhi(w[u]);
            const float ms = wave_sum(x0 * x0 + x1 * x1) * (1.0f / 128.0f), rs = rsqrtf(ms + 1e-6f);
            const float* gp = (hh < 8 ? qn : kn) + 2 * lane;
            const float n0 = x0 * rs * gp[0], n1 = x1 * rs * gp[1];
            const float pos = (lane < 32) ? (float)(t >> 6) : (float)(t & 63);
            const float ang = pos * inv, kk = rintf(ang * 0.15915494309189535f); float rr = fmaf(-kk, 6.2831854820251465f, ang); rr = fmaf(kk, 1.7484555e-07f, rr); const float sn = __sinf(rr), cs = __cosf(rr);
            if (it < MTOK * 10) *(unsigned*)(proj + (size_t)token * CDIN + 1024 + hh * 128 + 2 * lane) = pk2(n0 * cs - n1 * sn, n0 * sn + n1 * cs); } } }
    for (long it = (long)lbid() * 512 + tid; it < (long)MTOK * 128; it += (long)lgdim() * 512) {
        const int token = (int)(it >> 7), ch = (int)(it & 127) * 8, t = token & 2047, hw = 1 << (ch >> 8);
        const int lo = max(t - hw, 0), hi = min(t + hw, SEQ);
        const bf16_t* cp = proj + (size_t)(token - t) * CDIN + ch;
        u32x4 wv[16];
#pragma unroll
        for (int k = 0; k < 16; ++k) { const int tt = t - hw + k; const bool ok = (k < 2 * hw) && (tt >= 0) && (tt < SEQ); wv[k] = ok ? *(const u32x4*)(cp + (size_t)tt * CDIN) : (u32x4){0u, 0u, 0u, 0u}; }
        const u32x4 xw = *(const u32x4*)(cp + (size_t)t * CDIN);
        float s[8];
#pragma unroll
        for (int i = 0; i < 8; ++i) s[i] = 0.f;
#pragma unroll
        for (int k = 0; k < 16; ++k) { s[0] += bflo(wv[k].x); s[1] += bfhi(wv[k].x); s[2] += bflo(wv[k].y); s[3] += bfhi(wv[k].y); s[4] += bflo(wv[k].z); s[5] += bfhi(wv[k].z); s[6] += bflo(wv[k].w); s[7] += bfhi(wv[k].w); }
        const float rn = 1.0f / (float)(hi - lo);
        const float xs[8] = {bflo(xw.x), bfhi(xw.x), bflo(xw.y), bfhi(xw.y), bflo(xw.z), bfhi(xw.z), bflo(xw.w), bfhi(xw.w)};
        u32x4 o; o.x = pk2(s[0] * rn - xs[0], s[1] * rn - xs[1]); o.y = pk2(s[2] * rn - xs[2], s[3] * rn - xs[3]); o.z = pk2(s[4] * rn - xs[4], s[5] * rn - xs[5]); o.w = pk2(s[6] * rn - xs[6], s[7] * rn - xs[7]);
        *(u32x4*)(pooled + (size_t)token * 1024 + ch) = o;
    }
}


#define XB_TMO      128
#define XB_XCNT(j)  (256  + 64 * (j))
#define XB_XSUB(j)  (1280 + 64 * (j))
#define XB_XGEN(j)  (2304 + 64 * (j))
#define XB_TOP      3328
#define XB_TOPGEN   3392
#define XCD_BAR_WORDS 3456
#define XB_SPIN_CAP (1u << 18)
#define LAS __attribute__((address_space(3)))

__device__ __forceinline__ unsigned xb_ld(unsigned* p)              { return __hip_atomic_load(p, __ATOMIC_RELAXED, __HIP_MEMORY_SCOPE_AGENT); }
__device__ __forceinline__ unsigned xb_add(unsigned* p, unsigned v) { return __hip_atomic_fetch_add(p, v, __ATOMIC_RELAXED, __HIP_MEMORY_SCOPE_AGENT); }
__device__ __forceinline__ unsigned xb_xcc_id() { return (unsigned)__builtin_amdgcn_s_getreg((3 << 11) | 20) & 0xFu; }
#define XB_SPIN(cond, bar) do { unsigned _sp = 0; while (cond) { __builtin_amdgcn_s_sleep(1); \
    if ((++_sp & 255u) == 0u) { if (xb_ld(&(bar)[XB_TMO])) break; if (_sp > XB_SPIN_CAP) { atomicAdd(&(bar)[XB_TMO], 1u); break; } } } } while (0)

struct XcdBarrier {
    unsigned* bar; unsigned x;
    volatile LAS unsigned* st;
};

__device__ __forceinline__ XcdBarrier xcd_barrier_post(unsigned* bar, volatile LAS unsigned* st) {
    XcdBarrier b; b.bar = bar; b.x = xb_xcc_id(); b.st = st;
    if (ltid() == 0) (void)xb_add(&bar[XB_XCNT(b.x)], 1u);
    return b;
}
__device__ __forceinline__ void xcd_barrier_complete(unsigned* bar, unsigned x, unsigned& nloc, unsigned& nx) {
    const unsigned G = lgdim() * gridDim.y * gridDim.z;
    unsigned sum, cnt, mine, sp = 0u;
    for (;;) {
        sum = 0u; cnt = 0u; mine = 0u;
#pragma unroll
        for (unsigned j = 0; j < 16; ++j) { const unsigned c = xb_ld(&bar[XB_XCNT(j)]); sum += c; cnt += (c > 0u) ? 1u : 0u; mine = (j == x) ? c : mine; }
        if (sum == G) break;
        __builtin_amdgcn_s_sleep(1);
        if ((++sp & 255u) == 0u) { if (xb_ld(&bar[XB_TMO])) break; if (sp > XB_SPIN_CAP) { atomicAdd(&bar[XB_TMO], 1u); break; } }
    }
    nloc = mine > 0u ? mine : 1u; nx = cnt > 0u ? cnt : 1u;
}

__device__ __forceinline__ void xcd_barrier(const XcdBarrier& b) {
    asm volatile("s_waitcnt vmcnt(0)" ::: "memory");
    __syncthreads();
    if (ltid() == 0) {
        unsigned* bar = b.bar;
        __builtin_amdgcn_s_waitcnt(0);
        unsigned nloc = b.st[0], nx = b.st[1];
        if (nloc == 0u) { xcd_barrier_complete(bar, b.x, nloc, nx); b.st[0] = nloc; b.st[1] = nx; }
        const unsigned old = xb_add(&bar[XB_XSUB(b.x)], 1u);
        const unsigned gen = old / nloc;
        if (old + 1u == (gen + 1u) * nloc) {
            __builtin_amdgcn_fence(__ATOMIC_RELEASE, "agent");
            asm volatile("s_waitcnt vmcnt(0)" ::: "memory");
            const unsigned og = xb_add(&bar[XB_TOP], 1u);
            const unsigned tg = og / nx;
            if (og + 1u == (tg + 1u) * nx) xb_add(&bar[XB_TOPGEN], 1u);
            else XB_SPIN(xb_ld(&bar[XB_TOPGEN]) == tg, bar);
            __builtin_amdgcn_fence(__ATOMIC_ACQUIRE, "agent");
            xb_add(&bar[XB_XGEN(b.x)], 1u);
            asm volatile("s_waitcnt vmcnt(0)" ::: "memory");
        } else {
            XB_SPIN(xb_ld(&bar[XB_XGEN(b.x)]) == gen, bar);
            __builtin_amdgcn_fence(__ATOMIC_ACQUIRE, "agent");
            asm volatile("s_waitcnt vmcnt(0)" ::: "memory");
        }
    }
    __syncthreads();
}


__global__ void __launch_bounds__(512, 2) mega(Params p_unused) {
    extern __shared__ __attribute__((aligned(16))) unsigned char lds[];
    typedef const __attribute__((address_space(4))) Params* KP;
    KP kp = (KP)__builtin_amdgcn_kernarg_segment_ptr();
    const int ph_lo = kp->ph_lo, ph_hi = kp->ph_hi;
    volatile LAS unsigned* const xst = (volatile LAS unsigned*)((LAS unsigned char*)lds + 151552);
    if (ltid() == 0) { xst[0] = 0u; xst[1] = 0u; }
    __syncthreads();
    if (ph_hi - ph_lo > 1) (void)xcd_barrier_post((unsigned*)(kp->ws + WS_BAR), xst);
    for (int ph = ph_lo; ph < ph_hi; ++ph) {
        asm volatile("" : "+s"(kp));
        const int tid = ltid(), wid = tid >> 6;
        unsigned char* const ws = kp->ws;
#define PIN(k) (kp->in[k])
        bf16_t* const w_abin = (bf16_t*)(ws + WS_ABIN); bf16_t* const w_about = (bf16_t*)(ws + WS_ABOUT); bf16_t* const w_cdin = (bf16_t*)(ws + WS_CDIN); bf16_t* const w_cdout = (bf16_t*)(ws + WS_CDOUT);
        bf16_t* const w_pool = (bf16_t*)(ws + WS_POOL); bf16_t* const w_gu = (bf16_t*)(ws + WS_GU); bf16_t* const w_down = (bf16_t*)(ws + WS_DOWN);
        bf16_t* const xb = (bf16_t*)(ws + WS_XB); float* const of = (float*)(ws + WS_XB); float* const ob = (float*)(ws + WS_OB);
        unsigned char* const R = ws + WS_R;
        bf16_t* const proj = (bf16_t*)R; bf16_t* const pooled = (bf16_t*)(R + R_POOLED); bf16_t* const mixout = (bf16_t*)(R + R_MIX);
        float* const y = (float*)R; bf16_t* const Hb = (bf16_t*)R; float* const y2 = (float*)(R + R_Y2);
#define XOUT (kp->out)
        const int L = (ph - 1) >> 3, s = (ph - 1) & 7, j = L >> 1; const bool isab = (L & 1) == 0;
        int gk = -1; pg8::Gemm g{}; bf16_t* eo = nullptr; int eld = 0; const float* ecs = nullptr; float* ef = nullptr; int ea0 = 1 << 30, ea1 = 1 << 30, ea2 = 1 << 30;
        if (ph == 0) {
            float* tile = (float*)lds;
            { const int cb = lbid(), cn = lgdim();
              for (int q = 0; q < 2; ++q) {
                cvt_tr(PIN(1) + (size_t)q * DM * ABIN, DM, ABIN, w_abin + (size_t)q * ABIN * DM, DM, 0, tile, cb, cn);
                cvt_tr(PIN(2) + (size_t)q * DM * DM, DM, DM, w_about + (size_t)q * DM * DM, DM, 0, tile, cb, cn);
                cvt_tr(PIN(6) + (size_t)q * DM * CDIN, DM, CDIN, w_cdin + (size_t)q * CDIN * DM, DM, 0, tile, cb, cn);
                cvt_tr(PIN(7) + (size_t)q * DM * DM, DM, DM, w_cdout + (size_t)q * DM * DM, DM, 0, tile, cb, cn);
                for (int gi = 0; gi < 4; ++gi) cvt_tr(PIN(8) + (size_t)(q * 4 + gi) * 65536, 256, 256, w_pool + (size_t)(q * 4 + gi) * 65536, 256, 0, tile, cb, cn);
              }
              for (int l = 0; l < 4; ++l) {
                cvt_tr(PIN(14) + (size_t)l * DM * FFH, DM, FFH, w_gu + (size_t)l * 2 * FFH * DM, DM, 1, tile, cb, cn);
                cvt_tr(PIN(15) + (size_t)l * DM * FFH, DM, FFH, w_gu + (size_t)l * 2 * FFH * DM, DM, 2, tile, cb, cn);
                cvt_tr(PIN(16) + (size_t)l * FFH * DM, FFH, DM, w_down + (size_t)l * DM * FFH, FFH, 0, tile, cb, cn);
              } }
            const float* x = PIN(0);
            { const long xs = (long)lgdim() * 512;
              for (long i0 = (long)lbid() * 512 + tid; i0 < (long)MTOK * DM / 4; i0 += 4 * xs) { f32x4 v[4];
#pragma unroll
                for (int u = 0; u < 4; ++u) { const long i = i0 + u * xs; v[u] = (i < (long)MTOK * DM / 4) ? *(const f32x4*)(x + i * 4) : (f32x4){0.f, 0.f, 0.f, 0.f}; }
#pragma unroll
                for (int u = 0; u < 4; ++u) { const long i = i0 + u * xs; if (i < (long)MTOK * DM / 4) {
                    u32x2 w; w.x = pk2(v[u][0], v[u][1]); w.y = pk2(v[u][2], v[u][3]); *(u32x2*)(xb + i * 4) = w; } } } }
        } else if (s == 0) {
            if (isab) { g = pg8::Gemm{xb, w_abin + (size_t)j * ABIN * DM, MTOK, ABIN, DM, DM, 0}; eo = proj; eld = ABIN; ea0 = 12; ea1 = 16; ea2 = 24; }
            else      { g = pg8::Gemm{xb, w_cdin + (size_t)j * CDIN * DM, MTOK, CDIN, DM, DM, 0}; eo = proj; eld = CDIN; }
            gk = 0;
        } else if (s == 1) {
            if (isab) {
                const int G = lgdim(), nh = (G > 128) ? 128 : 0;
#ifndef NO_HGRN
                for (int item = lbid(); item < 128; item += G)
                    hgrn_dir(proj, PIN(4), j, ((item >> 3) & 1) ? ob : of, (item & 7) | ((item >> 4) << 3), (item >> 3) & 1, (PG8_LAS unsigned char*)lds);
#endif
#ifndef NO_NA
                if (lbid() >= nh) na_mfma(proj, PIN(3) + (size_t)j * 8 * 465, mixout, lbid() - nh, G - nh, (PG8_LAS unsigned char*)lds);
#endif
            } else {
#ifndef NO_PREP
                cd_prep(proj, PIN(10) + j * 128, PIN(11) + j * 128, pooled);
#endif
            }
        } else if (s == 2) {
            if (isab) hgrn_combine(of, ob, proj, PIN(5) + j * 1024, mixout);
            if (!isab) {
#ifndef NO_ATT
                for (int u = lbid(); u < 512; u += lgdim()) {
                    const int qb = u & 7, h = (u >> 3) & 7, b = u >> 6;
                    const bf16_t* qp = proj + (size_t)(b * SEQ + qb * 256) * CDIN + 1024 + h * 128;
                    const bf16_t* kp = proj + (size_t)(b * SEQ) * CDIN + 2048 + (h >> 2) * 128;
                    att::attn_dense_body<att::bf16>((const att::bf16*)qp, (const att::bf16*)kp, (const att::bf16*)(kp + 256), mixout + (size_t)(b * SEQ + qb * 256) * DM + 1024 + h * 128, SEQ, (char*)lds);
                    __syncthreads();
                }
#endif
                g = pg8::Gemm{pooled, w_pool + (size_t)j * 4 * 65536, MTOK, 1024, 256, 1024, 512}; eo = mixout; eld = DM; ecs = PIN(9) + j * 1024; gk = 4;
            }
        } else if (s == 3) {
            g = pg8::Gemm{mixout, (isab ? w_about : w_cdout) + (size_t)j * DM * DM, MTOK, DM, DM, DM, 0}; ef = y; gk = 1;
        } else if (s == 4) {
            ln_phase(XOUT, xb, PIN(12) + L * DM, PIN(13) + L * DM, (float*)(ws + WS_XCH), false);
        } else if (s == 5) {
            g = pg8::Gemm{xb, w_gu + (size_t)L * 2 * FFH * DM, MTOK, 2 * FFH, DM, DM, 0}; gk = 2;
        } else if (s == 6) {
            g = pg8::Gemm{Hb, w_down + (size_t)L * DM * FFH, MTOK, DM, FFH, FFH, 0}; ef = y2; gk = 3;
        } else {
            ln_phase(XOUT, xb, PIN(17) + L * DM, PIN(18) + L * DM, (float*)(ws + WS_XCH), L == 3);
        }
        if (gk >= 0) {
            pg8::StaticOrder S; S.init(g.M, g.N, lgdim(), lbid());
            PG8_LAS unsigned char* l3 = (PG8_LAS unsigned char*)lds;
            if (gk == 0) { pg8::EpiBf16S E{eo, eld, nullptr, ea0, ea1, ea2}; pg8::gemm_phase<pg8::EpiBf16S, pg8::StaticOrder, true, true, 2048, 2048, 0>(l3, g, S, E); }
            else if (gk == 1) { pg8::EpiF32 E{XOUT, (L == 0) ? PIN(0) : (const float*)XOUT, DM, DN_ALPHA, (L == 0) ? nullptr : (const float*)(ws + WS_XCH), PIN(17) + (L - 1) * DM, PIN(18) + (L - 1) * DM}; pg8::gemm_phase<pg8::EpiF32, pg8::StaticOrder, true, true, 2048, 2048, 0>(l3, g, S, E); }
            else if (gk == 2) { pg8::EpiSwiGLU E{Hb, FFH}; pg8::gemm_phase<pg8::EpiSwiGLU, pg8::StaticOrder, true, true, 2048, 2048, 0>(l3, g, S, E); }
            else if (gk == 3) { pg8::EpiF32 E{XOUT, (const float*)XOUT, DM, DN_ALPHA, (const float*)(ws + WS_XCH), PIN(12) + L * DM, PIN(13) + L * DM}; pg8::gemm_phase<pg8::EpiF32, pg8::StaticOrder, true, true, 5632, 5632, 0>(l3, g, S, E); }
            else { pg8::EpiBf16S E{eo, eld, ecs, 1 << 30, 1 << 30, 1 << 30}; pg8::gemm_phase<pg8::EpiBf16S, pg8::StaticOrder, true, true, 256, 1024, 512>(l3, g, S, E); }
        }
        if (ph + 1 < ph_hi) {
            if (ph == 0) cg::this_grid().sync();
            else { XcdBarrier xb; xb.bar = (unsigned*)(kp->ws + WS_BAR); xb.x = xb_xcc_id(); xb.st = xst; xcd_barrier(xb); } }
    }
}

extern "C" void kernel_launch(void* const* d_in, const int* in_sizes, int n_in, void* d_out, int out_size, void* d_ws, size_t ws_size, hipStream_t stream) {
    static int grid = 0;
    if (grid == 0) {
        if (n_in != 19 || out_size != MTOK * DM || ws_size < WS_TOTAL) { fprintf(stderr, "kernel_launch: unexpected shapes n_in %d out %d ws %zu (need %zu)\n", n_in, out_size, ws_size, (size_t)WS_END); grid = -1; return; }
        int dev = 0, cus = 0, per_cu = 0;
        hipGetDevice(&dev); hipDeviceGetAttribute(&cus, hipDeviceAttributeMultiprocessorCount, dev);
        if (hipFuncSetAttribute((const void*)mega, hipFuncAttributeMaxDynamicSharedMemorySize, LDS_BYTES) != hipSuccess) { fprintf(stderr, "kernel_launch: hipFuncSetAttribute failed\n"); grid = -1; return; }
        if (hipOccupancyMaxActiveBlocksPerMultiprocessor(&per_cu, (const void*)mega, 512, LDS_BYTES) != hipSuccess || per_cu < 1) { fprintf(stderr, "kernel_launch: occupancy query gave %d\n", per_cu); per_cu = 1; }
        (void)hipGetLastError();
        grid = cus * 1;
    }
    if (grid < 0) return;
    Params p{};
    for (int i = 0; i < 19; ++i) p.in[i] = (const float*)d_in[i];
    p.out = (float*)d_out; p.ws = (unsigned char*)d_ws;
#if MK_SINGLE
    if (hipMemsetAsync((char*)d_ws + WS_BAR, 0, XCD_BAR_WORDS * 4, stream) != hipSuccess) { fprintf(stderr, "kernel_launch: memset of the barrier words failed\n"); return; }
    p.ph_lo = 0; p.ph_hi = NPH;
    void* args[] = {&p};
    hipError_t e = hipLaunchCooperativeKernel((const void*)mega, dim3(grid), dim3(512), args, LDS_BYTES, stream);
    if (e != hipSuccess) fprintf(stderr, "cooperative launch failed: %s (grid %d)\n", hipGetErrorString(e), grid);
#else
    for (int ph = 0; ph < NPH; ++ph) {
        if (ph >= 1) { const int L = (ph - 1) >> 3, s = (ph - 1) & 7; if (s == 2 && (L & 1) == 0) continue; }
        p.ph_lo = ph; p.ph_hi = ph + 1;
        hipLaunchKernelGGL(mega, dim3(grid), dim3(512), LDS_BYTES, stream, p);
    }
#endif
}
```

```cpp
#include <hip/hip_runtime.h>
#include <hip/hip_bf16.h>
#include <hip/hip_cooperative_groups.h>
#include <cstdio>
#include <cstdint>
namespace cg = cooperative_groups;
__device__ __forceinline__ int ltid() { int t = __builtin_amdgcn_workitem_id_x(); asm volatile("" : "+v"(t)); return t; }
__device__ __forceinline__ int lbid() { int t = __builtin_amdgcn_workgroup_id_x(); asm volatile("" : "+s"(t)); return t; }
__device__ __forceinline__ int lgdim() { int t = (int)__ockl_get_num_groups(0); asm volatile("" : "+s"(t)); return t; }

#ifndef MK_SINGLE
#define MK_SINGLE 1
#endif

namespace pg8 {
#define PG8_LAS __attribute__((address_space(3)))
typedef unsigned short bf16_t;
typedef short bf16x8 __attribute__((ext_vector_type(8)));
typedef float f32x4 __attribute__((ext_vector_type(4)));
typedef unsigned u32x4 __attribute__((ext_vector_type(4)));
constexpr int BM = 256, BK = 64, HALF = 128, HTB = HALF * BK * 2  , STAGE_BYTES = 8 * HTB, NXCD = 8, WGM = 4;

__host__ __device__ __forceinline__ int lds_byte(int r, int c) { const int st = (r >> 4) * 2 + (c >> 5), rr = r & 15, cc = c & 31, ob = rr * 64 + cc * 2; return st * 1024 + (ob ^ (((ob >> 9) & 1) << 5)); }
__host__ __device__ __forceinline__ void stage_rc(int b, int& R, int& C) { const int st = b / 1024, sb = b % 1024, swz = sb ^ (((sb >> 9) & 1) << 5); R = (st >> 1) * 16 + swz / 64; C = (st & 1) * 32 + (swz % 64) / 2; }
__host__ __device__ __forceinline__ int perm32(int rho) { const int n = rho >> 4, i = rho & 15; return 8 * (i >> 2) + 4 * n + (i & 3); }

struct Unit { int pm, pn; };
struct Gemm { const bf16_t* A; const bf16_t* Bt; int M, N, K, lda; long apn; };

struct StaticOrder {
    int nM, nN, nwg, G, c;
    __host__ __device__ void init(int M, int N, int G_, int c_) { nM = M / BM; nN = N / BM; nwg = nM * nN; G = G_; c = c_; }
    __host__ __device__ bool next(int i, Unit& u) const {
        const long L = (long)i * G + c; if (L >= nwg) return false;
        int wgid = (int)L; { const int q = nwg / NXCD, r = nwg % NXCD, xcd = wgid % NXCD, off = wgid / NXCD; wgid = (xcd < r ? xcd * (q + 1) : r * (q + 1) + (xcd - r) * q) + off; }
        const int nig = WGM * nN, gid = wgid / nig, fm = gid * WGM, gsz = (nM - fm) < WGM ? (nM - fm) : WGM;
        u.pm = fm + ((wgid % nig) % gsz); u.pn = (wgid % nig) / gsz; return true;
    }
    __device__ __forceinline__ void a_ready(const Unit&) const {}
    __device__ __forceinline__ void done(const Unit&) const {}
};

__device__ __forceinline__ unsigned cvt_pk_bf16(float lo, float hi) { unsigned r; asm volatile("v_cvt_pk_bf16_f32 %0, %1, %2" : "=v"(r) : "v"(lo), "v"(hi)); return r; }
typedef float f32x2 __attribute__((ext_vector_type(2)));

struct EpiBf16S {
    static constexpr bool PERM = true, AFTER_DRAIN = false;
    bf16_t* O; int ldc; const float* cs; int a0, a1, a2;
    __device__ __forceinline__ void operator()(const f32x4 (&acc)[2][2][4][2], const Unit& u, int wr, int wc, int fr, int fq) const {
        const int row0 = u.pm * BM + wr * 64 + fr, col0 = u.pn * BM + wc * 32 + 8 * fq;
        const int act = (u.pn >= a0 && u.pn < a1) ? 1 : ((u.pn >= a1 && u.pn < a2) ? 2 : 0);
        f32x4 sv[2][2];
#pragma unroll
        for (int bj = 0; bj < 2; ++bj)
#pragma unroll
            for (int n = 0; n < 2; ++n) sv[bj][n] = cs ? *(const f32x4*)(cs + col0 + bj * HALF + 4 * n) : (f32x4){1.f, 1.f, 1.f, 1.f};
#pragma unroll
        for (int ai = 0; ai < 2; ++ai)
#pragma unroll
            for (int m = 0; m < 4; ++m) { bf16_t* rowp = O + (size_t)(row0 + ai * HALF + m * 16) * ldc + col0;
#pragma unroll
                for (int bj = 0; bj < 2; ++bj) { f32x4 v0 = acc[ai][bj][m][0] * sv[bj][0], v1 = acc[ai][bj][m][1] * sv[bj][1];
                    if (act) {
#pragma unroll
                        for (int e = 0; e < 4; ++e) { const float s0 = __builtin_amdgcn_rcpf(1.0f + __builtin_amdgcn_exp2f(-1.4426950408889634f * v0[e])), s1 = __builtin_amdgcn_rcpf(1.0f + __builtin_amdgcn_exp2f(-1.4426950408889634f * v1[e]));
                            v0[e] = (act == 1) ? v0[e] * s0 : s0; v1[e] = (act == 1) ? v1[e] * s1 : s1; } }
                    u32x4 w; w.x = cvt_pk_bf16(v0[0], v0[1]); w.y = cvt_pk_bf16(v0[2], v0[3]); w.z = cvt_pk_bf16(v1[0], v1[1]); w.w = cvt_pk_bf16(v1[2], v1[3]);
                    *(u32x4*)(rowp + bj * HALF) = w; } }
    }
};
struct EpiF32 {
    static constexpr bool PERM = false, AFTER_DRAIN = false;
    float* O; const float* R; int ldc; float alpha; const float* st; const float* g; const float* b;
    __device__ __forceinline__ void operator()(const f32x4 (&acc)[2][2][4][2], const Unit& u, int wr, int wc, int fr, int fq) const {
        const int row0 = u.pm * BM + wr * 64 + fr, col0 = u.pn * BM + wc * 32 + 4 * fq;
        f32x4 gv[2][2], bv[2][2];
#pragma unroll
        for (int bj = 0; bj < 2; ++bj)
#pragma unroll
            for (int n = 0; n < 2; ++n) { gv[bj][n] = st ? *(const f32x4*)(g + col0 + bj * HALF + n * 16) : (f32x4){1.f, 1.f, 1.f, 1.f}; bv[bj][n] = st ? *(const f32x4*)(b + col0 + bj * HALF + n * 16) : (f32x4){0.f, 0.f, 0.f, 0.f}; }
#pragma unroll
        for (int ai = 0; ai < 2; ++ai)
#pragma unroll
            for (int m = 0; m < 4; ++m) { const int row = row0 + ai * HALF + m * 16; float* rowp = O + (size_t)row * ldc + col0; const float* rsrc = R + (size_t)row * ldc + col0;
                float mean = 0.f, rstd = 1.f; if (st) { mean = st[2 * row]; rstd = st[2 * row + 1]; }
                f32x4 xr[2][2];
#pragma unroll
                for (int bj = 0; bj < 2; ++bj)
#pragma unroll
                    for (int n = 0; n < 2; ++n) xr[bj][n] = *(const f32x4*)(rsrc + bj * HALF + n * 16);
#pragma unroll
                for (int bj = 0; bj < 2; ++bj)
#pragma unroll
                    for (int n = 0; n < 2; ++n) { const f32x4 xn = (xr[bj][n] - mean) * rstd * gv[bj][n] + bv[bj][n]; *(f32x4*)(rowp + bj * HALF + n * 16) = acc[ai][bj][m][n] + xn * alpha; }
                asm volatile("" ::: "memory"); }
    }
};
struct EpiSwiGLU {
    static constexpr bool PERM = true, AFTER_DRAIN = false;
    bf16_t* Hh; int ldh;
    __device__ __forceinline__ void operator()(const f32x4 (&acc)[2][2][4][2], const Unit& u, int wr, int wc, int fr, int fq) const {
        const int row0 = u.pm * BM + wr * 64 + fr, col0 = u.pn * HALF + wc * 32 + 8 * fq;
#pragma unroll
        for (int ai = 0; ai < 2; ++ai)
#pragma unroll
            for (int m = 0; m < 4; ++m) { bf16_t* rowp = Hh + (size_t)(row0 + ai * HALF + m * 16) * ldh + col0;
                float h[8];
#pragma unroll
                for (int n = 0; n < 2; ++n)
#pragma unroll
                    for (int e = 0; e < 4; ++e) { const float g = acc[ai][0][m][n][e], up = acc[ai][1][m][n][e];
                        const float sg = __builtin_amdgcn_rcpf(1.0f + __builtin_amdgcn_exp2f(-1.4426950408889634f * g));
                        h[n * 4 + e] = g * sg * up; }
                u32x4 w; w.x = cvt_pk_bf16(h[0], h[1]); w.y = cvt_pk_bf16(h[2], h[3]); w.z = cvt_pk_bf16(h[4], h[5]); w.w = cvt_pk_bf16(h[6], h[7]);
                *(u32x4*)rowp = w; }
    }
};
template <class Epi, class Sched, bool ALIGN_EPI, bool SP2, int KC, int LDA, int APN>
__device__ __forceinline__ void gemm_phase(PG8_LAS unsigned char* lds, const Gemm g, const Sched& S, const Epi& E) {
    const int tid = ltid(), wid = __builtin_amdgcn_readfirstlane(tid >> 6), lane = tid & 63, wr = wid >> 2, wc = wid & 3, fr = lane & 15, fq = lane >> 4;
    constexpr int K = KC, nt = K / BK;
    unsigned voffA[2], voffB[2];
#pragma unroll
    for (int i = 0; i < 2; ++i) { int R, C; stage_rc(tid * 16 + i * 8192, R, C); const int Rb = Epi::PERM ? ((R & ~31) + perm32(R & 31)) : R;
        voffA[i] = (unsigned)(R * LDA + C) * 2u; voffB[i] = (unsigned)(Rb * K + C) * 2u; }
    const size_t kstep = (size_t)(BK * 2);
    const size_t hstepB = (size_t)HALF * K * 2, hstepA = (size_t)HALF * LDA * 2;
    const size_t tstepB = 2 * hstepB, tstepA = 2 * hstepA;
    const unsigned ldsw = (unsigned)wid * 1024u;
    const int aoff = lds_byte(wr * 64 + fr, fq * 8), boff = lds_byte(wc * 32 + fr, fq * 8);
#define PG8_SA(b, h) (((b) * 2 + (h)) * HTB)
#define PG8_SB(b, h) ((4 + (b) * 2 + (h)) * HTB)
#define PG8_STAGE(bufoff, gbase, voff) do { const char* _gb = (const char*)(gbase); asm volatile("" : "+s"(_gb)); _Pragma("unroll") for (int _i = 0; _i < 2; ++_i) \
        __builtin_amdgcn_global_load_lds((const unsigned*)(_gb + (voff)[_i]), (PG8_LAS unsigned*)(lds + (bufoff) + ldsw + _i * 8192), 16, 0, 0); } while (0)
#define PG8_LDA(dst, b, h) do { _Pragma("unroll") for (int m = 0; m < 4; ++m) _Pragma("unroll") for (int k = 0; k < 2; ++k) dst[m][k] = *(const PG8_LAS bf16x8*)(lds + PG8_SA(b, h) + aoff + m * 2048 + k * 1024); } while (0)
#define PG8_LDB(dst, b, h) do { _Pragma("unroll") for (int n = 0; n < 2; ++n) _Pragma("unroll") for (int k = 0; k < 2; ++k) dst[n][k] = *(const PG8_LAS bf16x8*)(lds + PG8_SB(b, h) + boff + n * 2048 + k * 1024); } while (0)
#define PG8_MMA(ai, bj, At, Bt) do { __builtin_amdgcn_s_setprio(1); _Pragma("unroll") for (int m = 0; m < 4; ++m) _Pragma("unroll") for (int n = 0; n < 2; ++n) _Pragma("unroll") for (int k = 0; k < 2; ++k) \
        acc[ai][bj][m][n] = __builtin_amdgcn_mfma_f32_16x16x32_bf16(Bt[n][k], At[m][k], acc[ai][bj][m][n], 0, 0, 0); __builtin_amdgcn_s_setprio(0); } while (0)
#define PG8_WAIT_V(n) asm volatile("s_waitcnt vmcnt(" #n ")" ::: "memory")
#define PG8_WAIT_L(n) asm volatile("s_waitcnt lgkmcnt(" #n ")" ::: "memory")
#define PG8_BAR __builtin_amdgcn_s_barrier()
#define PG8_SCHED __builtin_amdgcn_sched_barrier(0)
    Unit cur, nxt; int ui = 0;
    if (!S.next(0, cur)) return;
    f32x4 acc[2][2][4][2];
#pragma unroll
    for (int a = 0; a < 2; ++a)
#pragma unroll
        for (int b = 0; b < 2; ++b)
#pragma unroll
            for (int m = 0; m < 4; ++m)
#pragma unroll
                for (int n = 0; n < 2; ++n) acc[a][b][m][n] = (f32x4){0.f, 0.f, 0.f, 0.f};
    bf16x8 At[4][2], B0[2][2], B1[2][2];
    const char* cA = (const char*)g.A + (size_t)cur.pm * tstepA + (size_t)cur.pn * APN; const char* cB = (const char*)g.Bt + (size_t)cur.pn * tstepB;
    S.a_ready(cur);
    if constexpr (SP2) {
        PG8_STAGE(PG8_SB(0, 0), cB, voffB); PG8_STAGE(PG8_SB(0, 1), cB + hstepB, voffB); PG8_STAGE(PG8_SA(0, 0), cA, voffA); PG8_STAGE(PG8_SA(0, 1), cA + hstepA, voffA);
        if (wr == 1) PG8_BAR;
        PG8_WAIT_V(2); PG8_BAR;
        PG8_STAGE(PG8_SB(1, 0), cB + kstep, voffB); PG8_STAGE(PG8_SA(1, 0), cA + kstep, voffA); PG8_STAGE(PG8_SB(1, 1), cB + hstepB + kstep, voffB);
        PG8_WAIT_V(6); PG8_BAR;
    } else {
        PG8_STAGE(PG8_SB(0, 0), cB, voffB); PG8_STAGE(PG8_SA(0, 0), cA, voffA); PG8_STAGE(PG8_SB(0, 1), cB + hstepB, voffB); PG8_STAGE(PG8_SA(0, 1), cA + hstepA, voffA);
        if (wr == 1) PG8_BAR;
        PG8_WAIT_V(4); PG8_BAR;
        PG8_STAGE(PG8_SB(1, 0), cB + kstep, voffB); PG8_STAGE(PG8_SA(1, 0), cA + kstep, voffA); PG8_STAGE(PG8_SB(1, 1), cB + hstepB + kstep, voffB);
        PG8_WAIT_V(6); PG8_BAR;
    }
    for (;;) {
        const bool has_next = S.next(ui + 1, nxt);
        const char* nA = has_next ? (const char*)g.A + (size_t)nxt.pm * tstepA + (size_t)nxt.pn * APN : cA; const char* nB = has_next ? (const char*)g.Bt + (size_t)nxt.pn * tstepB : cB;
        for (int t = 0; t < nt; t += 2) {
            const bool last = (t == nt - 2);
            const char* a1 = cA + (size_t)(t + 1) * kstep;
            const char* a2 = last ? nA : cA + (size_t)(t + 2) * kstep; const char* b2 = last ? nB : cB + (size_t)(t + 2) * kstep;
            const char* a3 = a2 + kstep; const char* b3 = b2 + kstep;
            if (last && has_next) S.a_ready(nxt);
            if constexpr (SP2) {
            PG8_LDB(B0, 0, 0); PG8_LDB(B1, 0, 1); PG8_SCHED; PG8_LDA(At, 0, 0); PG8_STAGE(PG8_SA(1, 1), a1 + hstepA, voffA);
            PG8_WAIT_V(8); PG8_WAIT_L(0); PG8_BAR; PG8_MMA(0, 0, At, B0); PG8_MMA(0, 1, At, B1); PG8_BAR; PG8_SCHED;
            PG8_LDA(At, 0, 1); PG8_STAGE(PG8_SB(0, 0), b2, voffB); PG8_STAGE(PG8_SB(0, 1), b2 + hstepB, voffB); PG8_STAGE(PG8_SA(0, 0), a2, voffA);
            PG8_WAIT_V(8); PG8_WAIT_L(0); PG8_BAR; PG8_MMA(1, 0, At, B0); PG8_MMA(1, 1, At, B1); PG8_BAR; PG8_SCHED;
            PG8_LDB(B0, 1, 0); PG8_LDB(B1, 1, 1); PG8_SCHED; PG8_LDA(At, 1, 0); PG8_STAGE(PG8_SA(0, 1), a2 + hstepA, voffA);
            PG8_WAIT_V(8); PG8_WAIT_L(0); PG8_BAR; PG8_MMA(0, 0, At, B0); PG8_MMA(0, 1, At, B1); PG8_BAR; PG8_SCHED;
            PG8_LDA(At, 1, 1); PG8_STAGE(PG8_SB(1, 0), b3, voffB); PG8_STAGE(PG8_SB(1, 1), b3 + hstepB, voffB); PG8_STAGE(PG8_SA(1, 0), a3, voffA);
            PG8_WAIT_V(8); PG8_WAIT_L(0); PG8_BAR; PG8_MMA(1, 0, At, B0); PG8_MMA(1, 1, At, B1); PG8_BAR; PG8_SCHED;
            } else {
            PG8_LDB(B0, 0, 0); PG8_SCHED; PG8_LDA(At, 0, 0); PG8_STAGE(PG8_SA(1, 1), a1 + hstepA, voffA);
            PG8_WAIT_L(8); PG8_BAR; PG8_WAIT_L(0); PG8_MMA(0, 0, At, B0); PG8_BAR; PG8_SCHED;
            PG8_LDB(B1, 0, 1); PG8_STAGE(PG8_SB(0, 0), b2, voffB);
            PG8_BAR; PG8_WAIT_L(0); PG8_MMA(0, 1, At, B1); PG8_BAR;
            PG8_LDA(At, 0, 1); PG8_STAGE(PG8_SA(0, 0), a2, voffA);
            PG8_BAR; PG8_WAIT_L(0); PG8_MMA(1, 0, At, B0); PG8_BAR; PG8_SCHED;
            PG8_STAGE(PG8_SB(0, 1), b2 + hstepB, voffB);
            PG8_WAIT_V(6); PG8_BAR; PG8_MMA(1, 1, At, B1); PG8_BAR;
            PG8_LDB(B0, 1, 0); PG8_SCHED; PG8_LDA(At, 1, 0); PG8_STAGE(PG8_SA(0, 1), a2 + hstepA, voffA);
            PG8_WAIT_L(8); PG8_BAR; PG8_WAIT_L(0); PG8_MMA(0, 0, At, B0); PG8_BAR; PG8_SCHED;
            PG8_LDB(B1, 1, 1); PG8_STAGE(PG8_SB(1, 0), b3, voffB);
            PG8_BAR; PG8_WAIT_L(0); PG8_MMA(0, 1, At, B1); PG8_BAR;
            PG8_LDA(At, 1, 1); PG8_STAGE(PG8_SA(1, 0), a3, voffA);
            PG8_BAR; PG8_WAIT_L(0); PG8_MMA(1, 0, At, B0); PG8_BAR; PG8_SCHED;
            PG8_STAGE(PG8_SB(1, 1), b3 + hstepB, voffB);
            PG8_WAIT_V(6); PG8_BAR; PG8_MMA(1, 1, At, B1); PG8_BAR;
            }
        }
        if constexpr (ALIGN_EPI) { if (wr == 0) PG8_BAR; }
        if constexpr (!Epi::AFTER_DRAIN) { E(acc, cur, wr, wc, fr, fq); S.done(cur); }
        if (!has_next) break;
#pragma unroll
        for (int a = 0; a < 2; ++a)
#pragma unroll
            for (int b = 0; b < 2; ++b)
#pragma unroll
                for (int m = 0; m < 4; ++m)
#pragma unroll
                    for (int n = 0; n < 2; ++n) acc[a][b][m][n] = (f32x4){0.f, 0.f, 0.f, 0.f};
        cur = nxt; cA = nA; cB = nB; ++ui;
        if constexpr (ALIGN_EPI) { if (wr == 1) PG8_BAR; }
    }
    PG8_WAIT_V(0);
    if constexpr (!ALIGN_EPI) { if (wr == 0) PG8_BAR; }
    PG8_BAR;
    if constexpr (Epi::AFTER_DRAIN) { E.fused(acc, cur, wr, wc, fr, fq, lds, wid, lane); S.done(cur); }
#undef PG8_SA
#undef PG8_SB
#undef PG8_STAGE
#undef PG8_LDA
#undef PG8_LDB
#undef PG8_MMA
#undef PG8_WAIT_V
#undef PG8_WAIT_L
#undef PG8_BAR
#undef PG8_SCHED
}
}


namespace att {
using bf16 = __hip_bfloat16;
constexpr int D = 128, NW = 8, QBLK = 32, KVBLK = 64;
constexpr float SCALE = 0.088388347648318440f;
constexpr float THR = 8.f;
constexpr int SDEPTH = 2;
constexpr int LDQ = 2560, LDK = 2560, LDO = 2048;
constexpr size_t SHM_V = KVBLK * D * 2, SHM_K = KVBLK * D * 2, SHM_ATTN = 2 * SHM_V + 2 * SHM_K + NW * 64 * 4;
using bf16x8 = __attribute__((ext_vector_type(8))) short;
using s16x4  = __attribute__((ext_vector_type(4))) short;
using f32x16 = __attribute__((ext_vector_type(16))) float;
using f32x8  = __attribute__((ext_vector_type(8))) float;
using u32x4  = __attribute__((ext_vector_type(4))) unsigned;
#define KSWZ(row, colB) ((row) * 256 + ((colB) ^ (((row) & 7) << 4)))
#define SBAR() __builtin_amdgcn_sched_barrier(0)
__device__ __forceinline__ int crow(int r, int hi) { return (r & 3) + 8 * (r >> 2) + 4 * hi; }
__device__ __forceinline__ unsigned cvtpk(float lo, float hi) {
  unsigned r; asm volatile("v_cvt_pk_bf16_f32 %0, %1, %2" : "=v"(r) : "v"(lo), "v"(hi)); return r;
}
template <typename TIn> struct Stage;
template <> struct Stage<bf16>  { using T = bf16x8;
  __device__ static __forceinline__ T ld8(const bf16* p) { return *reinterpret_cast<const bf16x8*>(p); }
  __device__ static __forceinline__ bf16x8 tobf(T x) { return x; } };
template <> struct Stage<float> { using T = f32x8;
  __device__ static __forceinline__ T ld8(const float* p) { return *reinterpret_cast<const f32x8*>(p); }
  __device__ static __forceinline__ bf16x8 tobf(T x) {
    u32x4 w = {cvtpk(x[0], x[1]), cvtpk(x[2], x[3]), cvtpk(x[4], x[5]), cvtpk(x[6], x[7])}; return *reinterpret_cast<bf16x8*>(&w); } };

__device__ __forceinline__ void partialSM(f32x16& p0, f32x16& p1, float& m_reg, float& mn, float& alpha) {
  constexpr float C = SCALE * 1.4426950408889634f;
  float pmax = p0[0]; for (int r = 1; r < 16; ++r) pmax = fmaxf(pmax, p0[r]); for (int r = 0; r < 16; ++r) pmax = fmaxf(pmax, p1[r]);
  { auto rr = __builtin_amdgcn_permlane32_swap(__float_as_uint(pmax), __float_as_uint(pmax), false, false);
    pmax = fmaxf(__uint_as_float(rr[0]), __uint_as_float(rr[1])); }
  if (__builtin_expect(__all(pmax - m_reg <= THR / SCALE), 1)) { mn = m_reg; alpha = 1.f; }
  else { mn = fmaxf(m_reg, pmax); alpha = __builtin_amdgcn_exp2f((m_reg - mn) * C); m_reg = mn; }
  float mnC = -mn * C;
  for (int r = 0; r < 16; ++r) p0[r] = fmaf(p0[r], C, mnC); for (int r = 0; r < 16; ++r) p1[r] = fmaf(p1[r], C, mnC);
  for (int r = 0; r < 16; ++r) p0[r] = __builtin_amdgcn_exp2f(p0[r]);
}
__device__ __forceinline__ void finishSM(f32x16& p0, f32x16& p1, float alpha, float& l_reg, bf16x8& pa0, bf16x8& pa1, bf16x8& pa2, bf16x8& pa3) {
  for (int r = 0; r < 16; ++r) p1[r] = __builtin_amdgcn_exp2f(p1[r]);
  float ps = 0; for (int r = 0; r < 16; ++r) ps += p0[r]; for (int r = 0; r < 16; ++r) ps += p1[r];
  { auto rr = __builtin_amdgcn_permlane32_swap(__float_as_uint(ps), __float_as_uint(ps), false, false);
    ps = __uint_as_float(rr[0]) + __uint_as_float(rr[1]); }
  l_reg = l_reg * alpha + ps;
#define PK4(P, BASE, OUT) do { unsigned a0 = cvtpk(P[BASE + 0], P[BASE + 1]), a1 = cvtpk(P[BASE + 2], P[BASE + 3]);   \
    unsigned b0 = cvtpk(P[BASE + 4], P[BASE + 5]), b1 = cvtpk(P[BASE + 6], P[BASE + 7]);                              \
    auto r0 = __builtin_amdgcn_permlane32_swap(a0, b0, false, false); auto r1 = __builtin_amdgcn_permlane32_swap(a1, b1, false, false); \
    u32x4 w = {r0[0], r1[0], r0[1], r1[1]}; OUT = *reinterpret_cast<bf16x8*>(&w); } while (0)
  PK4(p0, 0, pa0); PK4(p0, 8, pa1); PK4(p1, 0, pa2); PK4(p1, 8, pa3);
#undef PK4
}
__device__ __forceinline__ void qkt(f32x16& p0, f32x16& p1, const bf16* Ks, const bf16x8* qr, int r32, int hi) {
  p0 = f32x16{}; p1 = f32x16{};
  for (int d0 = 0; d0 < 8; ++d0) { int cb = (d0 * 16 + hi * 8) * 2;
    bf16x8 b0 = *reinterpret_cast<const bf16x8*>((const char*)Ks + KSWZ(r32, cb));
    bf16x8 b1 = *reinterpret_cast<const bf16x8*>((const char*)Ks + KSWZ(32 + r32, cb));
    p0 = __builtin_amdgcn_mfma_f32_32x32x16_bf16(b0, qr[d0], p0, 0, 0, 0);
    p1 = __builtin_amdgcn_mfma_f32_32x32x16_bf16(b1, qr[d0], p1, 0, 0, 0); }
}
__device__ __forceinline__ int v_st(int k, int c) { const int kk = (k & ~0xC) | ((k & 4) << 1) | ((k & 8) >> 1); return ((kk >> 3) * 4 + (c >> 5)) * 512 + ((kk & 7) * 32 + (c & 31)) * 2; }
__device__ __forceinline__ int v_rd_base(int lane) { return ((lane & 3) << 3) | (((lane >> 2) & 3) << 6) | (((lane >> 4) & 1) << 5) | (((lane >> 5) & 1) << 8); }
constexpr int v_rd_off(int d0, int ks, int half) { return d0 * 512 + ks * 4096 + half * 2048; }
template <int OFF> __device__ __forceinline__ s16x4 tr_read(int vb) {
  s16x4 r; asm volatile("ds_read_b64_tr_b16 %0, %1 offset:%2" : "=&v"(r) : "v"(vb), "i"(OFF) : "memory"); return r;
}
template <int D0> __device__ __forceinline__ void pv_one(f32x16& od, int vb, bf16x8 pa0, bf16x8 pa1, bf16x8 pa2, bf16x8 pa3) {
  const s16x4 l0 = tr_read<v_rd_off(D0, 0, 0)>(vb), h0 = tr_read<v_rd_off(D0, 0, 1)>(vb), l1 = tr_read<v_rd_off(D0, 1, 0)>(vb), h1 = tr_read<v_rd_off(D0, 1, 1)>(vb);
  const s16x4 l2 = tr_read<v_rd_off(D0, 2, 0)>(vb), h2 = tr_read<v_rd_off(D0, 2, 1)>(vb), l3 = tr_read<v_rd_off(D0, 3, 0)>(vb), h3 = tr_read<v_rd_off(D0, 3, 1)>(vb);
  asm volatile("s_waitcnt lgkmcnt(0)" ::: "memory"); SBAR();
#define PK(L, H) (bf16x8){L[0], L[1], L[2], L[3], H[0], H[1], H[2], H[3]}
  od = __builtin_amdgcn_mfma_f32_32x32x16_bf16(pa0, PK(l0, h0), od, 0, 0, 0);
  od = __builtin_amdgcn_mfma_f32_32x32x16_bf16(pa1, PK(l1, h1), od, 0, 0, 0);
  od = __builtin_amdgcn_mfma_f32_32x32x16_bf16(pa2, PK(l2, h2), od, 0, 0, 0);
  od = __builtin_amdgcn_mfma_f32_32x32x16_bf16(pa3, PK(l3, h3), od, 0, 0, 0);
#undef PK
}
__device__ __forceinline__ void pv_d0(f32x16* o, int vb, bf16x8 pa0, bf16x8 pa1, bf16x8 pa2, bf16x8 pa3) {
  pv_one<0>(o[0], vb, pa0, pa1, pa2, pa3); pv_one<1>(o[1], vb, pa0, pa1, pa2, pa3); pv_one<2>(o[2], vb, pa0, pa1, pa2, pa3); pv_one<3>(o[3], vb, pa0, pa1, pa2, pa3);
}


template <typename TQ>
__device__ __forceinline__ void attn_dense_body(const TQ* __restrict__ Qb, const bf16* __restrict__ Kh, const bf16* __restrict__ Vh,
                                                unsigned short* __restrict__ Ob, int seq, char* lds) {
  using St = Stage<bf16>; using SQ = Stage<TQ>;
  const int tid = ltid(), wid = tid >> 6, lane = tid & 63, r32 = lane & 31, hi = lane >> 5;
  bf16* V_lds = (bf16*)lds; bf16* K_lds = (bf16*)(lds + 2 * SHM_V);
  float* ws = (float*)(lds + 2 * SHM_V + 2 * SHM_K) + wid * 64; float* li_l = ws; float* al_l = ws + 32;
  float m_reg = -1e30f, l_reg = 0; f32x16 o[4] = {}; bf16x8 qr[8];
  const TQ* Qw = Qb + (long)(wid * QBLK + r32) * LDQ + hi * 8;
#pragma unroll
  for (int d0 = 0; d0 < 8; ++d0) qr[d0] = SQ::tobf(SQ::ld8(Qw + d0 * 16));
  const int sr = tid >> 4, sc = (tid & 15) * 8, vst0 = v_st(sr, sc), vst1 = v_st(32 + sr, sc);
  const int vb0 = (int)(uintptr_t)V_lds + v_rd_base(lane);
  struct { typename St::T vs0, vs1, ks0, ks1; } sr_[SDEPTH];
#define SLOAD(i, k0) do { sr_[i].vs0 = St::ld8(&Vh[(long)((k0) + sr) * LDK + sc]); sr_[i].vs1 = St::ld8(&Vh[(long)((k0) + 32 + sr) * LDK + sc]); \
    sr_[i].ks0 = St::ld8(&Kh[(long)((k0) + sr) * LDK + sc]); sr_[i].ks1 = St::ld8(&Kh[(long)((k0) + 32 + sr) * LDK + sc]); } while (0)
#define SWRITE(b, i) do { *(bf16x8*)((char*)V_lds + (b) * SHM_V + vst0) = St::tobf(sr_[i].vs0);          \
    *(bf16x8*)((char*)V_lds + (b) * SHM_V + vst1) = St::tobf(sr_[i].vs1); int kc = sc * 2;               \
    *(bf16x8*)((char*)K_lds + (b) * SHM_K + KSWZ(sr, kc)) = St::tobf(sr_[i].ks0);                       \
    *(bf16x8*)((char*)K_lds + (b) * SHM_K + KSWZ(32 + sr, kc)) = St::tobf(sr_[i].ks1); } while (0)
#define SWAIT() do { if constexpr (SDEPTH == 2) asm volatile("s_waitcnt vmcnt(4)" ::: "memory"); else asm volatile("s_waitcnt vmcnt(0)" ::: "memory"); } while (0)
#define RESC(a) do { if (__any((a) < 1.f)) { if (hi == 0) al_l[r32] = (a); asm volatile("s_waitcnt lgkmcnt(0)" ::: "memory"); \
    for (int d = 0; d < 4; ++d) for (int r = 0; r < 16; ++r) o[d][r] *= al_l[crow(r, hi)]; } } while (0)
  f32x16 pA0, pA1, pB0, pB1; float mnA, mnB, alA, alB; bf16x8 pa0, pa1, pa2, pa3; const int NT = seq / KVBLK;
  constexpr int SE = 0, SO = SDEPTH - 1;
  SLOAD(SE, 0); asm volatile("s_waitcnt vmcnt(0)" ::: "memory"); SWRITE(0, SE); __syncthreads();
  qkt(pA0, pA1, K_lds, qr, r32, hi); partialSM(pA0, pA1, m_reg, mnA, alA);
  SLOAD(SO, KVBLK); if constexpr (SDEPTH == 2) { if (2 < NT) SLOAD(SE, 2 * KVBLK); }
  SWAIT(); SWRITE(1, SO); __syncthreads();
  for (int j = 1; j + 1 < NT; j += 2) {
    SBAR(); qkt(pB0, pB1, (bf16*)((char*)K_lds + SHM_K), qr, r32, hi);
    finishSM(pA0, pA1, alA, l_reg, pa0, pa1, pa2, pa3); SBAR();
    SLOAD(SO, (j + SDEPTH) * KVBLK); SBAR();
    pv_d0(o, vb0, pa0, pa1, pa2, pa3); partialSM(pB0, pB1, m_reg, mnB, alB);
    __syncthreads(); SWAIT(); SWRITE(0, SE);
    RESC(alB); __syncthreads();
    SBAR(); qkt(pA0, pA1, K_lds, qr, r32, hi);
    finishSM(pB0, pB1, alB, l_reg, pa0, pa1, pa2, pa3); SBAR();
    if (SDEPTH == 1 || j + 3 < NT) SLOAD(SE, (j + 1 + SDEPTH) * KVBLK); SBAR();
    pv_d0(o, vb0 + (int)SHM_V, pa0, pa1, pa2, pa3); partialSM(pA0, pA1, m_reg, mnA, alA);
    __syncthreads(); SWAIT(); SWRITE(1, SO);
    RESC(alA); __syncthreads();
  }
  SBAR(); qkt(pB0, pB1, (bf16*)((char*)K_lds + SHM_K), qr, r32, hi);
  finishSM(pA0, pA1, alA, l_reg, pa0, pa1, pa2, pa3); SBAR();
  pv_d0(o, vb0, pa0, pa1, pa2, pa3); partialSM(pB0, pB1, m_reg, mnB, alB);
  __syncthreads(); RESC(alB);
  finishSM(pB0, pB1, alB, l_reg, pa0, pa1, pa2, pa3); SBAR();
  pv_d0(o, vb0 + (int)SHM_V, pa0, pa1, pa2, pa3);
  if (hi == 0) li_l[r32] = l_reg; asm volatile("s_waitcnt lgkmcnt(0)" ::: "memory");
  float rli[16];
#pragma unroll
  for (int r = 0; r < 16; ++r) rli[r] = __builtin_amdgcn_rcpf(li_l[crow(r, hi)]);
  unsigned short* Ow = Ob + (long)(wid * QBLK) * LDO;
#pragma unroll
  for (int r = 0; r < 16; ++r) { int orow = crow(r, hi);
    for (int d0 = 0; d0 < 4; ++d0) { const float ov = o[d0][r] * rli[r]; Ow[(long)orow * LDO + d0 * 32 + r32] = (unsigned short)cvtpk(ov, ov); } }
#undef SLOAD
#undef SWRITE
#undef SWAIT
#undef RESC
}


}

typedef unsigned short bf16_t;
typedef float f32x4 __attribute__((ext_vector_type(4)));
typedef unsigned u32x4 __attribute__((ext_vector_type(4)));
typedef unsigned u32x2 __attribute__((ext_vector_type(2)));
constexpr int MTOK = 16384, DM = 2048, ABIN = 8192, CDIN = 2560, FFH = 5632, SEQ = 2048;
constexpr int NPH = 33;
constexpr float DN_ALPHA = 1.6817928305074290f;
constexpr size_t WS_ABIN = 0;
constexpr size_t WS_ABOUT = WS_ABIN + 2ull * ABIN * DM * 2;
constexpr size_t WS_CDIN = WS_ABOUT + 2ull * DM * DM * 2;
constexpr size_t WS_CDOUT = WS_CDIN + 2ull * CDIN * DM * 2;
constexpr size_t WS_POOL = WS_CDOUT + 2ull * DM * DM * 2;
constexpr size_t WS_GU = WS_POOL + 2ull * 4 * 256 * 256 * 2;
constexpr size_t WS_DOWN = WS_GU + 4ull * 2 * FFH * DM * 2;
constexpr size_t WS_XB = WS_DOWN + 4ull * DM * FFH * 2;
constexpr size_t WS_R = WS_XB + (size_t)MTOK * DM * 2;
constexpr size_t R_POOLED = (size_t)MTOK * CDIN * 2;
constexpr size_t R_MIX = (size_t)MTOK * ABIN * 2;
constexpr size_t R_Y2 = (size_t)MTOK * FFH * 2;
constexpr size_t WS_END = WS_R + R_MIX + (size_t)MTOK * DM * 2;
constexpr size_t WS_BAR = WS_END; constexpr size_t WS_OB = WS_BAR + 16384; constexpr size_t WS_XCH = WS_OB + (size_t)MTOK * 1024 * 4;
constexpr size_t WS_TOTAL = WS_XCH + (size_t)MTOK * 2 * 4;
constexpr int LDS_BYTES = 151552 + 16;

struct Params { const float* in[19]; float* out; unsigned char* ws; int ph_lo, ph_hi; };

__device__ __forceinline__ float bflo(unsigned w) { return __uint_as_float(w << 16); }
__device__ __forceinline__ float bfhi(unsigned w) { return __uint_as_float(w & 0xffff0000u); }
__device__ __forceinline__ unsigned pk2(float lo, float hi) { return pg8::cvt_pk_bf16(lo, hi); }
typedef float f32x2c_t __attribute__((ext_vector_type(2))); typedef __bf16 bf16x2c_t __attribute__((ext_vector_type(2)));
__device__ __forceinline__ unsigned pk2s(float lo, float hi) { f32x2c_t v = {lo, hi}; bf16x2c_t b = __builtin_convertvector(v, bf16x2c_t); return __builtin_bit_cast(unsigned, b); }
__device__ __forceinline__ float sigmoidf_(float z) { return 1.0f / (1.0f + __expf(-z)); }
template <int M> __device__ __forceinline__ float swz_xor(float v) { return __int_as_float(__builtin_amdgcn_ds_swizzle(__float_as_int(v), (M << 10) | 0x1f)); }
__device__ __forceinline__ float sum32(float v) { auto r = __builtin_amdgcn_permlane32_swap(__float_as_uint(v), __float_as_uint(v), false, false); return __uint_as_float(r[0]) + __uint_as_float(r[1]); }
__device__ __forceinline__ float max32(float v) { auto r = __builtin_amdgcn_permlane32_swap(__float_as_uint(v), __float_as_uint(v), false, false); return fmaxf(__uint_as_float(r[0]), __uint_as_float(r[1])); }
__device__ __forceinline__ float sum_lo32(float v) { v += swz_xor<16>(v); v += swz_xor<8>(v); v += swz_xor<4>(v); v += swz_xor<2>(v); v += swz_xor<1>(v); return v; }
__device__ __forceinline__ float wave_sum(float v) { return sum_lo32(sum32(v)); }
__device__ __forceinline__ float wave_max(float v) { v = max32(v); v = fmaxf(v, swz_xor<16>(v)); v = fmaxf(v, swz_xor<8>(v)); v = fmaxf(v, swz_xor<4>(v)); v = fmaxf(v, swz_xor<2>(v)); v = fmaxf(v, swz_xor<1>(v)); return v; }
#define LDS_FENCE() asm volatile("s_waitcnt lgkmcnt(0)" ::: "memory")

__device__ __forceinline__ void cvt_tr(const float* __restrict__ src, int K, int N, bf16_t* __restrict__ dst, int ldd, int mode, float* tile, int bid, int nb) {
    const int tid = ltid(), tn = N >> 6, nt = tn * (K >> 7);
    const int kr0 = tid >> 4, nc = (tid & 15) * 4;
    f32x4 r[4];
    if (bid < nt) { const int kt = bid / tn, k0 = kt * 128, n0 = (bid - kt * tn) * 64;
#pragma unroll
        for (int i = 0; i < 4; ++i) r[i] = *(const f32x4*)(src + (size_t)(k0 + kr0 + 32 * i) * N + n0 + nc); }
    for (int t = bid; t < nt; t += nb) {
        const int kt = t / tn, k0 = kt * 128, n0 = (t - kt * tn) * 64;
#pragma unroll
        for (int i = 0; i < 4; ++i) { float* tp = tile + (kr0 + 32 * i) * 65 + nc; tp[0] = r[i][0]; tp[1] = r[i][1]; tp[2] = r[i][2]; tp[3] = r[i][3]; }
        __syncthreads();
        if (t + nb < nt) { const int t2 = t + nb, kt2 = t2 / tn, k2 = kt2 * 128, n2 = (t2 - kt2 * tn) * 64;
#pragma unroll
            for (int i = 0; i < 4; ++i) r[i] = *(const f32x4*)(src + (size_t)(k2 + kr0 + 32 * i) * N + n2 + nc); }
        const int nr = tid >> 3, kc = (tid & 7) * 16;
        float v[16];
#pragma unroll
        for (int i = 0; i < 16; ++i) v[i] = tile[(kc + i) * 65 + nr];
        const int n = n0 + nr; const int drow = mode == 0 ? n : ((n >> 7) * 256 + (n & 127) + (mode == 2 ? 128 : 0));
        u32x4 w0, w1; w0.x = pk2(v[0], v[1]); w0.y = pk2(v[2], v[3]); w0.z = pk2(v[4], v[5]); w0.w = pk2(v[6], v[7]);
        w1.x = pk2(v[8], v[9]); w1.y = pk2(v[10], v[11]); w1.z = pk2(v[12], v[13]); w1.w = pk2(v[14], v[15]);
        bf16_t* dp = dst + (size_t)drow * ldd + k0 + kc; *(u32x4*)dp = w0; *(u32x4*)(dp + 8) = w1;
        __syncthreads();
    }
}

__device__ __forceinline__ void ln_phase(float* __restrict__ X, bf16_t* __restrict__ xb, const float* __restrict__ g, const float* __restrict__ b, float* __restrict__ st, bool writeX) {
    const int lane = ltid() & 63, wid = ltid() >> 6;
    for (int row = (lbid() * 8 + wid) * 4; row < MTOK; row += lgdim() * 32) {
        const size_t ro = (size_t)row * DM;
        f32x4 v[4][8]; float s[4] = {0.f, 0.f, 0.f, 0.f};
#pragma unroll
        for (int rr = 0; rr < 4; ++rr)
#pragma unroll
            for (int i = 0; i < 8; ++i) { const int c = (i * 64 + lane) * 4; v[rr][i] = *(const f32x4*)(X + ro + rr * DM + c); }
#pragma unroll
        for (int rr = 0; rr < 4; ++rr)
#pragma unroll
            for (int i = 0; i < 8; ++i) s[rr] += (v[rr][i][0] + v[rr][i][1]) + (v[rr][i][2] + v[rr][i][3]);
        float rstd[4];
#pragma unroll
        for (int rr = 0; rr < 4; ++rr) { const float mean = wave_sum(s[rr]) * (1.0f / DM); float q = 0.f;
#pragma unroll
            for (int i = 0; i < 8; ++i) { v[rr][i] = v[rr][i] - mean; q += (v[rr][i][0] * v[rr][i][0] + v[rr][i][1] * v[rr][i][1]) + (v[rr][i][2] * v[rr][i][2] + v[rr][i][3] * v[rr][i][3]); }
            rstd[rr] = rsqrtf(wave_sum(q) * (1.0f / DM) + 1e-5f);
            if (lane == 0) { st[2 * (row + rr)] = mean; st[2 * (row + rr) + 1] = rstd[rr]; } }
#pragma unroll
        for (int i = 0; i < 8; ++i) { const int c = (i * 64 + lane) * 4; const f32x4 gv = *(const f32x4*)(g + c), bv = *(const f32x4*)(b + c);
#pragma unroll
            for (int rr = 0; rr < 4; ++rr) { const f32x4 o = v[rr][i] * rstd[rr] * gv + bv; if (writeX) *(f32x4*)(X + ro + rr * DM + c) = o;
                u32x2 w; w.x = pk2(o[0], o[1]); w.y = pk2(o[2], o[3]); *(u32x2*)(xb + ro + rr * DM + c) = w; } }
    }
}

typedef short s16x8 __attribute__((ext_vector_type(8)));
typedef float f32x2g __attribute__((ext_vector_type(2)));
#define MFMA16(a, b, c) __builtin_amdgcn_mfma_f32_16x16x32_bf16(a, b, c, 0, 0, 0)
__device__ __forceinline__ s16x8 mk8(unsigned a, unsigned b, unsigned c, unsigned d) { u32x4 w = {a, b, c, d}; return *reinterpret_cast<s16x8*>(&w); }
__device__ __forceinline__ float clamp80(float x) { return fminf(fmaxf(x, -80.f), 80.f); }
constexpr int HD_TOT_OFF = 72704;
__device__ __forceinline__ void hgrn_dir(const bf16_t* __restrict__ proj, const float* __restrict__ lbl, int jl, bf16_t* __restrict__ odir, int bh, int dir, __attribute__((address_space(3))) unsigned char* lds) {
    typedef __attribute__((address_space(3))) unsigned char* L3p; typedef __attribute__((address_space(3))) bf16_t* L3h; typedef __attribute__((address_space(3))) float* L3f;
    typedef __attribute__((address_space(3))) u32x4* L3q;
    const int tid = ltid(), wv = __builtin_amdgcn_readfirstlane(tid >> 6), lane0 = tid & 63;
    const int b = bh >> 3, h = bh & 7;
    const L3p L = (L3p)lds;
    const L3f eRv = (L3f)L; const L3f eLv = eRv + 128;
    const L3h Qd = (L3h)(L + 1024); const L3h Kd = (L3h)(L + 18432); const L3h Pm = Kd; const L3h KdT = (L3h)(L + 35840); const L3h VT = (L3h)(L + 54272);
    const L3f tot = (L3f)(L + HD_TOT_OFF);
    float lb0 = 0.f, lb1 = 0.f;
    if (jl != 0) { const int ch = h * 128 + 2 * lane0; const f32x2g l0 = *(const f32x2g*)(lbl + ch), l1 = *(const f32x2g*)(lbl + 1024 + ch);
        { const float mx = fmaxf(l0.x, l1.x), e0 = __expf(l0.x - mx), e1 = __expf(l1.x - mx); lb0 = e1 / (e0 + e1); }
        { const float mx = fmaxf(l0.y, l1.y), e0 = __expf(l0.y - mx), e1 = __expf(l1.y - mx); lb1 = e1 / (e0 + e1); } }
    const float om0 = 1.f - lb0, om1 = 1.f - lb1;
    const size_t tok0 = (size_t)b * SEQ;
    const bf16_t* pbase = proj + h * 128 + 2 * lane0;
    const int zoff = dir ? 5120 : 4096;
    unsigned zr[8], qr[8], vr[8];
    f32x4 S[8];
#pragma unroll
    for (int i = 0; i < 8; ++i) S[i] = (f32x4){0.f, 0.f, 0.f, 0.f};
#define HD_T(k_, tau_) (dir ? ((31 - (k_)) * 64 + 63 - (tau_)) : ((k_) * 64 + (tau_)))
#define HD_LOAD(k_) do { _Pragma("unroll") for (int i = 0; i < 8; ++i) { const bf16_t* rp = pbase + (tok0 + HD_T(k_, 8 * wv + i)) * ABIN; \
        zr[i] = *(const unsigned*)(rp + zoff); qr[i] = *(const unsigned*)(rp + 3072); vr[i] = *(const unsigned*)(rp + 6144); } } while (0)
    HD_LOAD(0);
    for (int k = 0; k < 32; ++k) {
        int lane = lane0; asm volatile("" : "+v"(lane)); const int fr = lane & 15, fq = lane >> 4;
        float g0[8], g1[8]; unsigned kpk[8]; float T0 = 0.f, T1 = 0.f;
#pragma unroll
        for (int i = 0; i < 8; ++i) { const float s0 = bflo(zr[i]), s1 = bfhi(zr[i]);
            T0 += __logf(lb0 + om0 * s0); T1 += __logf(lb1 + om1 * s1); g0[i] = T0; g1[i] = T1; kpk[i] = pk2(om0 * (1.f - s0), om1 * (1.f - s1)); }
        *(__attribute__((address_space(3))) f32x2g*)(tot + wv * 128 + 2 * lane) = (f32x2g){T0, T1};
        __syncthreads();
        { float p0 = 0.f, p1 = 0.f, R0 = 0.f, R1 = 0.f, GL0 = 0.f, GL1 = 0.f;
#pragma unroll
          for (int q = 0; q < 8; ++q) { const f32x2g tq_ = *(const __attribute__((address_space(3))) f32x2g*)(tot + q * 128 + 2 * lane);
              if (q < wv) { p0 += tq_.x; p1 += tq_.y; } if (q < 4) { R0 += tq_.x; R1 += tq_.y; } GL0 += tq_.x; GL1 += tq_.y; }
          const float eLR0 = __expf(clamp80(GL0 - R0)), eLR1 = __expf(clamp80(GL1 - R1));
          if (wv == 0) { *(__attribute__((address_space(3))) f32x2g*)(eRv + 2 * lane) = (f32x2g){__expf(R0), __expf(R1)}; *(__attribute__((address_space(3))) f32x2g*)(eLv + 2 * lane) = (f32x2g){__expf(GL0), __expf(GL1)}; }
          unsigned kt0[4], kt1[4], vt0[4], vt1[4];
#pragma unroll
          for (int i = 0; i < 8; i += 2) { float kk0[2], kk1[2];
#pragma unroll
              for (int e = 0; e < 2; ++e) { const int ii = i + e;
                  const float E0 = __expf(clamp80(p0 + g0[ii] - R0)), E1 = __expf(clamp80(p1 + g1[ii] - R1));
                  const float qs0 = bflo(qr[ii]), qs1 = bfhi(qr[ii]);
                  const float kd0 = bflo(kpk[ii]) * __builtin_amdgcn_rcpf(E0), kd1 = bfhi(kpk[ii]) * __builtin_amdgcn_rcpf(E1);
                  *(__attribute__((address_space(3))) unsigned*)(Qd + (8 * wv + ii) * 136 + 2 * lane) = pk2(qs0 * E0, qs1 * E1);
                  *(__attribute__((address_space(3))) unsigned*)(Kd + (8 * wv + ii) * 136 + 2 * lane) = pk2(kd0, kd1);
                  kk0[e] = kd0 * eLR0; kk1[e] = kd1 * eLR1; }
              kt0[i >> 1] = pk2(kk0[0], kk0[1]); kt1[i >> 1] = pk2(kk1[0], kk1[1]);
              vt0[i >> 1] = (vr[i] & 0xffffu) | (vr[i + 1] << 16); vt1[i >> 1] = (vr[i] >> 16) | (vr[i + 1] & 0xffff0000u); }
          const L3h kp0 = KdT + (2 * lane) * 72 + 8 * wv; const L3h vp0 = VT + (2 * lane) * 72 + 8 * wv;
          *(L3q)kp0 = (u32x4){kt0[0], kt0[1], kt0[2], kt0[3]}; *(L3q)(kp0 + 72) = (u32x4){kt1[0], kt1[1], kt1[2], kt1[3]};
          *(L3q)vp0 = (u32x4){vt0[0], vt0[1], vt0[2], vt0[3]}; *(L3q)(vp0 + 72) = (u32x4){vt1[0], vt1[1], vt1[2], vt1[3]}; }
        if (k + 1 < 32) HD_LOAD(k + 1);
        __syncthreads();
        const int tb_ = wv & 3, sb0 = 2 * (wv >> 2);
        unsigned pw[2][2];
        { s16x8 qf[4];
#pragma unroll
          for (int ks = 0; ks < 4; ++ks) qf[ks] = *(const __attribute__((address_space(3))) s16x8*)(Qd + (16 * tb_ + fr) * 136 + 32 * ks + 8 * fq);
#pragma unroll
          for (int si = 0; si < 2; ++si) { const int sb = sb0 + si; f32x4 a = {0.f, 0.f, 0.f, 0.f};
              if (sb <= tb_) {
#pragma unroll
                  for (int ks = 0; ks < 4; ++ks) { const s16x8 kf = *(const __attribute__((address_space(3))) s16x8*)(Kd + (16 * sb + fr) * 136 + 32 * ks + 8 * fq); a = MFMA16(kf, qf[ks], a); }
                  if (sb == tb_) {
#pragma unroll
                      for (int r = 0; r < 4; ++r) if (4 * fq + r > fr) a[r] = 0.f; } }
              pw[si][0] = pk2s(a[0], a[1]); pw[si][1] = pk2s(a[2], a[3]); } }
        __syncthreads();
#pragma unroll
        for (int si = 0; si < 2; ++si) *(__attribute__((address_space(3))) u32x2*)(Pm + (16 * tb_ + fr) * 72 + 16 * (sb0 + si) + 4 * fq) = (u32x2){pw[si][0], pw[si][1]};
        f32x4 oacc[4];
#pragma unroll
        for (int tb = 0; tb < 4; ++tb) oacc[tb] = (f32x4){0.f, 0.f, 0.f, 0.f};
#pragma unroll
        for (int ks = 0; ks < 4; ++ks) {
            const f32x4 ea = *(const __attribute__((address_space(3))) f32x4*)(eRv + 32 * ks + 4 * fq), eb = *(const __attribute__((address_space(3))) f32x4*)(eRv + 32 * ks + 16 + 4 * fq);
            const f32x4 a = S[2 * ks] * ea, c = S[2 * ks + 1] * eb; const s16x8 xf = mk8(pk2(a[0], a[1]), pk2(a[2], a[3]), pk2(c[0], c[1]), pk2(c[2], c[3]));
#pragma unroll
            for (int tb = 0; tb < 4; ++tb) { const u32x2 qa = *(const __attribute__((address_space(3))) u32x2*)(Qd + (16 * tb + fr) * 136 + 32 * ks + 4 * fq), qb = *(const __attribute__((address_space(3))) u32x2*)(Qd + (16 * tb + fr) * 136 + 32 * ks + 16 + 4 * fq);
                oacc[tb] = MFMA16(xf, mk8(qa.x, qa.y, qb.x, qb.y), oacc[tb]); } }
        __syncthreads();
        s16x8 vf[2];
#pragma unroll
        for (int ks2 = 0; ks2 < 2; ++ks2) vf[ks2] = *(const __attribute__((address_space(3))) s16x8*)(VT + (16 * wv + fr) * 72 + 32 * ks2 + 8 * fq);
#pragma unroll
        for (int tb = 0; tb < 4; ++tb)
#pragma unroll
            for (int ks2 = 0; ks2 < 2; ++ks2) if (ks2 <= (tb >> 1)) { const s16x8 pf = *(const __attribute__((address_space(3))) s16x8*)(Pm + (16 * tb + fr) * 72 + 32 * ks2 + 8 * fq);
                oacc[tb] = MFMA16(vf[ks2], pf, oacc[tb]); }
#pragma unroll
        for (int tb = 0; tb < 4; ++tb) { const size_t token = tok0 + HD_T(k, 16 * tb + fr); *(u32x2*)(odir + token * 1024 + h * 128 + 16 * wv + 4 * fq) = (u32x2){pk2s(oacc[tb][0], oacc[tb][1]), pk2s(oacc[tb][2], oacc[tb][3])}; }
#pragma unroll
        for (int blk = 0; blk < 8; ++blk) { const f32x4 el = *(const __attribute__((address_space(3))) f32x4*)(eLv + 16 * blk + 4 * fq);
            S[blk] = S[blk] * el;
#pragma unroll
            for (int ks2 = 0; ks2 < 2; ++ks2) { const s16x8 kf = *(const __attribute__((address_space(3))) s16x8*)(KdT + (16 * blk + fr) * 72 + 32 * ks2 + 8 * fq); S[blk] = MFMA16(kf, vf[ks2], S[blk]); } }
    }
    __syncthreads();
#undef HD_T
#undef HD_LOAD
}
__device__ __forceinline__ void hgrn_combine(const bf16_t* __restrict__ of, const bf16_t* __restrict__ ob, const bf16_t* __restrict__ proj, const float* __restrict__ normw, bf16_t* __restrict__ mixout) {
    const long stride = (long)lgdim() * 512;
    for (long it0 = (long)lbid() * 512 + ltid(); it0 < (long)MTOK * 256; it0 += 4 * stride) {
        f32x4 o[4]; u32x2 gw[4];
#pragma unroll
        for (int u = 0; u < 4; ++u) { const long it = it0 + u * stride; if (it < (long)MTOK * 256) { const size_t token = (size_t)(it >> 8); const int col = (int)(it & 255) * 4;
            const u32x2 a = *(const u32x2*)(of + token * 1024 + col), c = *(const u32x2*)(ob + token * 1024 + col);
            o[u] = (f32x4){bflo(a.x) + bflo(c.x), bfhi(a.x) + bfhi(c.x), bflo(a.y) + bflo(c.y), bfhi(a.y) + bfhi(c.y)}; gw[u] = *(const u32x2*)(proj + token * ABIN + 7168 + col); } else { o[u] = (f32x4){0.f, 0.f, 0.f, 0.f}; gw[u] = (u32x2){0u, 0u}; } }
#pragma unroll
        for (int u = 0; u < 4; ++u) { const long it = it0 + u * stride; const size_t token = (size_t)(it >> 8); const int col = (int)(it & 255) * 4;
            float ss = (o[u][0] * o[u][0] + o[u][1] * o[u][1]) + (o[u][2] * o[u][2] + o[u][3] * o[u][3]);
            ss = sum_lo32(ss);
            const float rs = rsqrtf(ss * (1.0f / 128.0f) + 1e-6f);
            const f32x4 nw = *(const f32x4*)(normw + col);
            const float gg[4] = {bflo(gw[u].x), bfhi(gw[u].x), bflo(gw[u].y), bfhi(gw[u].y)}; float r[4];
#pragma unroll
            for (int i = 0; i < 4; ++i) r[i] = o[u][i] * rs * nw[i] * gg[i] * __builtin_amdgcn_rcpf(1.f + __expf(-gg[i]));
            if (it < (long)MTOK * 256) *(u32x2*)(mixout + token * DM + 1024 + col) = (u32x2){pk2(r[0], r[1]), pk2(r[2], r[3])}; }
    }
}

constexpr int NA_VT_BYTES = 2 * 128 * 72 * 2;
constexpr int NA_RPB_OFF = 2 * NA_VT_BYTES;
__device__ __forceinline__ void na_mfma(const bf16_t* __restrict__ proj, const float* __restrict__ rpb, bf16_t* __restrict__ mixout, int unit0, int ustride, __attribute__((address_space(3))) unsigned char* lds) {
    typedef __attribute__((address_space(3))) unsigned char* L3p; typedef __attribute__((address_space(3))) bf16_t* L3h; typedef __attribute__((address_space(3))) float* L3f;
    const int tid = ltid(), wv = __builtin_amdgcn_readfirstlane(tid >> 6), hd = wv >> 2, g = wv & 3, lane = tid & 63, fr = lane & 15, fq = lane >> 4;
    const L3f rl = (L3f)(lds + NA_RPB_OFF);
    for (int i = tid; i < 8 * 465; i += 512) rl[i] = rpb[i];
    const int cw = (g == 0) ? 0 : (g == 1) ? 8 : (g == 2) ? 24 : 32;
    const int c = 16 * g + fr, cs = min(max(c - 8, 0), 48);
    const int skp = tid & 31, spart = tid >> 5, shead = spart >> 3, sd0 = (spart & 7) * 16;
    __syncthreads();
    for (int unit = unit0; unit < 1024; unit += ustride) {
        const int hp = unit & 3, r = (unit >> 2) & 31, b = unit >> 7, h = hp * 2 + hd, r0 = min(max(r - 4, 0), 24);
        const size_t tokq = (size_t)b * SEQ + r * 64 + c;
        s16x8 qf[4];
#pragma unroll
        for (int ks = 0; ks < 4; ++ks) qf[ks] = *(const s16x8*)(proj + tokq * ABIN + h * 128 + 32 * ks + 8 * fq);
        const bf16_t* vsrc = proj + ((size_t)b * SEQ + r0 * 64 + 2 * skp) * ABIN + 2048 + (hp * 2 + shead) * 128 + sd0;
        u32x4 vreg[2][4];
#pragma unroll
        for (int q = 0; q < 4; ++q) { vreg[0][q] = *(const u32x4*)(vsrc + (size_t)(q >> 1) * ABIN + 8 * (q & 1)); vreg[1][q] = *(const u32x4*)(vsrc + (size_t)(64 + (q >> 1)) * ABIN + 8 * (q & 1)); }
        f32x4 sc[8][2];
        const bf16_t* kbase = proj + ((size_t)b * SEQ + r0 * 64 + cw + 8 * (fr >> 2) + (fr & 3)) * ABIN + 1024 + h * 128 + 8 * fq;
#pragma unroll
        for (int j = 0; j < 8; ++j)
#pragma unroll
            for (int hf = 0; hf < 2; ++hf) { f32x4 a = {0.f, 0.f, 0.f, 0.f};
#pragma unroll
                for (int ks = 0; ks < 4; ++ks) { const s16x8 kf = *(const s16x8*)(kbase + (size_t)(j * 64 + 4 * hf) * ABIN + 32 * ks); a = MFMA16(kf, qf[ks], a); }
                sc[j][hf] = a; }
        float mx = -3.0e38f;
#pragma unroll
        for (int j = 0; j < 8; ++j) { const int ro = h * 465 + (r0 + j - r + 7) * 31 + 15 - c;
#pragma unroll
            for (int hf = 0; hf < 2; ++hf)
#pragma unroll
                for (int e = 0; e < 4; ++e) { const int kc = cw + 8 * fq + 4 * hf + e; const bool ok = (kc >= cs) && (kc < cs + 16);
                    const float bias = rl[ok ? (ro + kc) : 0];
                    const float s = ok ? (sc[j][hf][e] * 0.088388347648318440f + bias) : -3.0e38f; sc[j][hf][e] = s; mx = fmaxf(mx, s); } }
        mx = fmaxf(mx, swz_xor<16>(mx)); mx = max32(mx);
        float sum = 0.f; s16x8 pf[8];
#pragma unroll
        for (int j = 0; j < 8; ++j) { float p[8];
#pragma unroll
            for (int hf = 0; hf < 2; ++hf)
#pragma unroll
                for (int e = 0; e < 4; ++e) { const float pv = __expf(sc[j][hf][e] - mx); p[hf * 4 + e] = pv; sum += pv; }
            pf[j] = mk8(pk2(p[0], p[1]), pk2(p[2], p[3]), pk2(p[4], p[5]), pk2(p[6], p[7])); }
        sum += swz_xor<16>(sum); sum = sum32(sum);
        const float inv = 1.0f / sum;
        f32x4 oacc[8];
#pragma unroll
        for (int db = 0; db < 8; ++db) oacc[db] = (f32x4){0.f, 0.f, 0.f, 0.f};
#pragma unroll
        for (int j = 0; j < 8; ++j) {
            const L3h vt = (L3h)(lds + (j & 1) * NA_VT_BYTES) + shead * (128 * 72) + sd0 * 72 + 2 * skp;
#pragma unroll
            for (int hh = 0; hh < 2; ++hh) { const unsigned a[4] = {vreg[j & 1][hh].x, vreg[j & 1][hh].y, vreg[j & 1][hh].z, vreg[j & 1][hh].w}, c[4] = {vreg[j & 1][2 + hh].x, vreg[j & 1][2 + hh].y, vreg[j & 1][2 + hh].z, vreg[j & 1][2 + hh].w};
#pragma unroll
                for (int e = 0; e < 4; ++e) { *(__attribute__((address_space(3))) unsigned*)(vt + (8 * hh + 2 * e) * 72) = (a[e] & 0xffffu) | (c[e] << 16);
                    *(__attribute__((address_space(3))) unsigned*)(vt + (8 * hh + 2 * e + 1) * 72) = (a[e] >> 16) | (c[e] & 0xffff0000u); } }
            __syncthreads();
            if (j + 2 < 8) {
#pragma unroll
                for (int q = 0; q < 4; ++q) vreg[j & 1][q] = *(const u32x4*)(vsrc + (size_t)((j + 2) * 64 + (q >> 1)) * ABIN + 8 * (q & 1)); }
            const L3h vr = (L3h)(lds + (j & 1) * NA_VT_BYTES) + hd * (128 * 72) + fr * 72 + cw + 8 * fq;
#pragma unroll
            for (int db = 0; db < 8; ++db) oacc[db] = MFMA16(*(const __attribute__((address_space(3))) s16x8*)(vr + db * 16 * 72), pf[j], oacc[db]);
        }
        bf16_t* op = mixout + tokq * DM + h * 128 + 4 * fq;
#pragma unroll
        for (int db = 0; db < 8; ++db) { const f32x4 o = oacc[db] * inv; *(u32x2*)(op + 16 * db) = (u32x2){pk2(o[0], o[1]), pk2(o[2], o[3])}; }
        __syncthreads();
    }
}

__device__ __forceinline__ void cd_prep(bf16_t* __restrict__ proj, const float* __restrict__ qn, const float* __restrict__ kn, bf16_t* __restrict__ pooled) {
    const int tid = ltid(), lane = tid & 63, wid = tid >> 6;
    const int nw = lgdim() * 8, w0 = lbid() * 8 + wid;
    { const int f = lane & 31; const float inv = exp2f(-(float)f * (13.287712379549449f / 32.0f));
      for (int it0 = w0; it0 < MTOK * 10; it0 += 4 * nw) {
        unsigned w[4];
#pragma unroll
        for (int u = 0; u < 4; ++u) { const int it = it0 + u * nw; const int token = it / 10, hh = it - token * 10;
            w[u] = (it < MTOK * 10) ? *(const unsigned*)(proj + (size_t)token * CDIN + 1024 + hh * 128 + 2 * lane) : 0u; }
#pragma unroll
        for (int u = 0; u < 4; ++u) { const int it = it0 + u * nw; const int token = it / 10, hh = it - token * 10, t = token & 2047;
            const float x0 = bflo(w[u]), x1 = bfhi(w[u]);
            const float ms = wave_sum(x0 * x0 + x1 * x1) * (1.0f / 128.0f), rs = rsqrtf(ms + 1e-6f);
            const float* gp = (hh < 8 ? qn : kn) + 2 * lane;
            const float n0 = x0 * rs * gp[0], n1 = x1 * rs * gp[1];
            const float pos = (lane < 32) ? (float)(t >> 6) : (float)(t & 63);
            const float ang = pos * inv, kk = rintf(ang * 0.15915494309189535f); float rr = fmaf(-kk, 6.2831854820251465f, ang); rr = fmaf(kk, 1.7484555e-07f, rr); const float sn = __sinf(rr), cs = __cosf(rr);
            if (it < MTOK * 10) *(unsigned*)(proj + (size_t)token * CDIN + 1024 + hh * 128 + 2 * lane) = pk2(n0 * cs - n1 * sn, n0 * sn + n1 * cs); } } }
    for (long it = (long)lbid() * 512 + tid; it < (long)MTOK * 128; it += (long)lgdim() * 512) {
        const int token = (int)(it >> 7), ch = (int)(it & 127) * 8, t = token & 2047, hw = 1 << (ch >> 8);
        const int lo = max(t - hw, 0), hi = min(t + hw, SEQ);
        const bf16_t* cp = proj + (size_t)(token - t) * CDIN + ch;
        u32x4 wv[16];
#pragma unroll
        for (int k = 0; k < 16; ++k) { const int tt = t - hw + k; const bool ok = (k < 2 * hw) && (tt >= 0) && (tt < SEQ); wv[k] = ok ? *(const u32x4*)(cp + (size_t)tt * CDIN) : (u32x4){0u, 0u, 0u, 0u}; }
        const u32x4 xw = *(const u32x4*)(cp + (size_t)t * CDIN);
        float s[8];
#pragma unroll
        for (int i = 0; i < 8; ++i) s[i] = 0.f;
#pragma unroll
        for (int k = 0; k < 16; ++k) { s[0] += bflo(wv[k].x); s[1] += bfhi(wv[k].x); s[2] += bflo(wv[k].y); s[3] += bfhi(wv[k].y); s[4] += bflo(wv[k].z); s[5] += bfhi(wv[k].z); s[6] += bflo(wv[k].w); s[7] += bfhi(wv[k].w); }
        const float rn = 1.0f / (float)(hi - lo);
        const float xs[8] = {bflo(xw.x), bfhi(xw.x), bflo(xw.y), bfhi(xw.y), bflo(xw.z), bfhi(xw.z), bflo(xw.w), bfhi(xw.w)};
        u32x4 o; o.x = pk2(s[0] * rn - xs[0], s[1] * rn - xs[1]); o.y = pk2(s[2] * rn - xs[2], s[3] * rn - xs[3]); o.z = pk2(s[4] * rn - xs[4], s[5] * rn - xs[5]); o.w = pk2(s[6] * rn - xs[6], s[7] * rn - xs[7]);
        *(u32x4*)(pooled + (size_t)token * 1024 + ch) = o;
    }
}


#define XB_TMO      128
#define XB_XCNT(j)  (256  + 64 * (j))
#define XB_XSUB(j)  (1280 + 64 * (j))
#define XB_XGEN(j)  (2304 + 64 * (j))
#define XB_TOP      3328
#define XB_TOPGEN   3392
#define XCD_BAR_WORDS 3456
#define XB_SPIN_CAP (1u << 18)
#define LAS __attribute__((address_space(3)))

__device__ __forceinline__ unsigned xb_ld(unsigned* p)              { return __hip_atomic_load(p, __ATOMIC_RELAXED, __HIP_MEMORY_SCOPE_AGENT); }
__device__ __forceinline__ unsigned xb_add(unsigned* p, unsigned v) { return __hip_atomic_fetch_add(p, v, __ATOMIC_RELAXED, __HIP_MEMORY_SCOPE_AGENT); }
__device__ __forceinline__ unsigned xb_xcc_id() { return (unsigned)__builtin_amdgcn_s_getreg((3 << 11) | 20) & 0xFu; }
#define XB_SPIN(cond, bar) do { unsigned _sp = 0; while (cond) { __builtin_amdgcn_s_sleep(1); \
    if ((++_sp & 255u) == 0u) { if (xb_ld(&(bar)[XB_TMO])) break; if (_sp > XB_SPIN_CAP) { atomicAdd(&(bar)[XB_TMO], 1u); break; } } } } while (0)

struct XcdBarrier {
    unsigned* bar; unsigned x;
    volatile LAS unsigned* st;
};

__device__ __forceinline__ XcdBarrier xcd_barrier_post(unsigned* bar, volatile LAS unsigned* st) {
    XcdBarrier b; b.bar = bar; b.x = xb_xcc_id(); b.st = st;
    if (ltid() == 0) (void)xb_add(&bar[XB_XCNT(b.x)], 1u);
    return b;
}
__device__ __forceinline__ void xcd_barrier_complete(unsigned* bar, unsigned x, unsigned& nloc, unsigned& nx) {
    const unsigned G = lgdim() * gridDim.y * gridDim.z;
    unsigned sum, cnt, mine, sp = 0u;
    for (;;) {
        sum = 0u; cnt = 0u; mine = 0u;
#pragma unroll
        for (unsigned j = 0; j < 16; ++j) { const unsigned c = xb_ld(&bar[XB_XCNT(j)]); sum += c; cnt += (c > 0u) ? 1u : 0u; mine = (j == x) ? c : mine; }
        if (sum == G) break;
        __builtin_amdgcn_s_sleep(1);
        if ((++sp & 255u) == 0u) { if (xb_ld(&bar[XB_TMO])) break; if (sp > XB_SPIN_CAP) { atomicAdd(&bar[XB_TMO], 1u); break; } }
    }
    nloc = mine > 0u ? mine : 1u; nx = cnt > 0u ? cnt : 1u;
}

__device__ __forceinline__ void xcd_barrier(const XcdBarrier& b) {
    asm volatile("s_waitcnt vmcnt(0)" ::: "memory");
    __syncthreads();
    if (ltid() == 0) {
        unsigned* bar = b.bar;
        __builtin_amdgcn_s_waitcnt(0);
        unsigned nloc = b.st[0], nx = b.st[1];
        if (nloc == 0u) { xcd_barrier_complete(bar, b.x, nloc, nx); b.st[0] = nloc; b.st[1] = nx; }
        const unsigned old = xb_add(&bar[XB_XSUB(b.x)], 1u);
        const unsigned gen = old / nloc;
        if (old + 1u == (gen + 1u) * nloc) {
            __builtin_amdgcn_fence(__ATOMIC_RELEASE, "agent");
            asm volatile("s_waitcnt vmcnt(0)" ::: "memory");
            const unsigned og = xb_add(&bar[XB_TOP], 1u);
            const unsigned tg = og / nx;
            if (og + 1u == (tg + 1u) * nx) xb_add(&bar[XB_TOPGEN], 1u);
            else XB_SPIN(xb_ld(&bar[XB_TOPGEN]) == tg, bar);
            __builtin_amdgcn_fence(__ATOMIC_ACQUIRE, "agent");
            xb_add(&bar[XB_XGEN(b.x)], 1u);
            asm volatile("s_waitcnt vmcnt(0)" ::: "memory");
        } else {
            XB_SPIN(xb_ld(&bar[XB_XGEN(b.x)]) == gen, bar);
            __builtin_amdgcn_fence(__ATOMIC_ACQUIRE, "agent");
            asm volatile("s_waitcnt vmcnt(0)" ::: "memory");
        }
    }
    __syncthreads();
}


__global__ void __launch_bounds__(512, 2) mega(Params p_unused) {
    extern __shared__ __attribute__((aligned(16))) unsigned char lds[];
    typedef const __attribute__((address_space(4))) Params* KP;
    KP kp = (KP)__builtin_amdgcn_kernarg_segment_ptr();
    const int ph_lo = kp->ph_lo, ph_hi = kp->ph_hi;
    volatile LAS unsigned* const xst = (volatile LAS unsigned*)((LAS unsigned char*)lds + 151552);
    if (ltid() == 0) { xst[0] = 0u; xst[1] = 0u; }
    __syncthreads();
    if (ph_hi - ph_lo > 1) (void)xcd_barrier_post((unsigned*)(kp->ws + WS_BAR), xst);
    for (int ph = ph_lo; ph < ph_hi; ++ph) {
        asm volatile("" : "+s"(kp));
        const int tid = ltid(), wid = tid >> 6;
        unsigned char* const ws = kp->ws;
#define PIN(k) (kp->in[k])
        bf16_t* const w_abin = (bf16_t*)(ws + WS_ABIN); bf16_t* const w_about = (bf16_t*)(ws + WS_ABOUT); bf16_t* const w_cdin = (bf16_t*)(ws + WS_CDIN); bf16_t* const w_cdout = (bf16_t*)(ws + WS_CDOUT);
        bf16_t* const w_pool = (bf16_t*)(ws + WS_POOL); bf16_t* const w_gu = (bf16_t*)(ws + WS_GU); bf16_t* const w_down = (bf16_t*)(ws + WS_DOWN);
        bf16_t* const xb = (bf16_t*)(ws + WS_XB); bf16_t* const of = (bf16_t*)(ws + WS_XB); bf16_t* const ob = (bf16_t*)(ws + WS_OB);
        unsigned char* const R = ws + WS_R;
        bf16_t* const proj = (bf16_t*)R; bf16_t* const pooled = (bf16_t*)(R + R_POOLED); bf16_t* const mixout = (bf16_t*)(R + R_MIX);
        float* const y = (float*)R; bf16_t* const Hb = (bf16_t*)R; float* const y2 = (float*)(R + R_Y2);
#define XOUT (kp->out)
        const int L = (ph - 1) >> 3, s = (ph - 1) & 7, j = L >> 1; const bool isab = (L & 1) == 0;
        int gk = -1; pg8::Gemm g{}; bf16_t* eo = nullptr; int eld = 0; const float* ecs = nullptr; float* ef = nullptr; int ea0 = 1 << 30, ea1 = 1 << 30, ea2 = 1 << 30;
        if (ph == 0) {
            float* tile = (float*)lds;
            { const int cb = lbid(), cn = lgdim();
              for (int q = 0; q < 2; ++q) {
                cvt_tr(PIN(1) + (size_t)q * DM * ABIN, DM, ABIN, w_abin + (size_t)q * ABIN * DM, DM, 0, tile, cb, cn);
                cvt_tr(PIN(2) + (size_t)q * DM * DM, DM, DM, w_about + (size_t)q * DM * DM, DM, 0, tile, cb, cn);
                cvt_tr(PIN(6) + (size_t)q * DM * CDIN, DM, CDIN, w_cdin + (size_t)q * CDIN * DM, DM, 0, tile, cb, cn);
                cvt_tr(PIN(7) + (size_t)q * DM * DM, DM, DM, w_cdout + (size_t)q * DM * DM, DM, 0, tile, cb, cn);
                for (int gi = 0; gi < 4; ++gi) cvt_tr(PIN(8) + (size_t)(q * 4 + gi) * 65536, 256, 256, w_pool + (size_t)(q * 4 + gi) * 65536, 256, 0, tile, cb, cn);
              }
              for (int l = 0; l < 4; ++l) {
                cvt_tr(PIN(14) + (size_t)l * DM * FFH, DM, FFH, w_gu + (size_t)l * 2 * FFH * DM, DM, 1, tile, cb, cn);
                cvt_tr(PIN(15) + (size_t)l * DM * FFH, DM, FFH, w_gu + (size_t)l * 2 * FFH * DM, DM, 2, tile, cb, cn);
                cvt_tr(PIN(16) + (size_t)l * FFH * DM, FFH, DM, w_down + (size_t)l * DM * FFH, FFH, 0, tile, cb, cn);
              } }
            const float* x = PIN(0);
            { const long xs = (long)lgdim() * 512;
              for (long i0 = (long)lbid() * 512 + tid; i0 < (long)MTOK * DM / 4; i0 += 4 * xs) { f32x4 v[4];
#pragma unroll
                for (int u = 0; u < 4; ++u) { const long i = i0 + u * xs; v[u] = (i < (long)MTOK * DM / 4) ? *(const f32x4*)(x + i * 4) : (f32x4){0.f, 0.f, 0.f, 0.f}; }
#pragma unroll
                for (int u = 0; u < 4; ++u) { const long i = i0 + u * xs; if (i < (long)MTOK * DM / 4) {
                    u32x2 w; w.x = pk2(v[u][0], v[u][1]); w.y = pk2(v[u][2], v[u][3]); *(u32x2*)(xb + i * 4) = w; } } } }
        } else if (s == 0) {
            if (isab) { g = pg8::Gemm{xb, w_abin + (size_t)j * ABIN * DM, MTOK, ABIN, DM, DM, 0}; eo = proj; eld = ABIN; ea0 = 12; ea1 = 16; ea2 = 24; }
            else      { g = pg8::Gemm{xb, w_cdin + (size_t)j * CDIN * DM, MTOK, CDIN, DM, DM, 0}; eo = proj; eld = CDIN; }
            gk = 0;
        } else if (s == 1) {
            if (isab) {
                const int G = lgdim(), nh = (G > 128) ? 128 : 0;
#ifndef NO_HGRN
                for (int item = lbid(); item < 128; item += G)
                    hgrn_dir(proj, PIN(4), j, (item & 1) ? ob : of, item >> 1, item & 1, (PG8_LAS unsigned char*)lds);
#endif
#ifndef NO_NA
                if (lbid() >= nh) na_mfma(proj, PIN(3) + (size_t)j * 8 * 465, mixout, lbid() - nh, G - nh, (PG8_LAS unsigned char*)lds);
#endif
            } else {
#ifndef NO_PREP
                cd_prep(proj, PIN(10) + j * 128, PIN(11) + j * 128, pooled);
#endif
            }
        } else if (s == 2) {
            if (isab) hgrn_combine(of, ob, proj, PIN(5) + j * 1024, mixout);
            if (!isab) {
#ifndef NO_ATT
                for (int u = lbid(); u < 512; u += lgdim()) {
                    const int qb = u & 7, h = (u >> 3) & 7, b = u >> 6;
                    const bf16_t* qp = proj + (size_t)(b * SEQ + qb * 256) * CDIN + 1024 + h * 128;
                    const bf16_t* kp = proj + (size_t)(b * SEQ) * CDIN + 2048 + (h >> 2) * 128;
                    att::attn_dense_body<att::bf16>((const att::bf16*)qp, (const att::bf16*)kp, (const att::bf16*)(kp + 256), mixout + (size_t)(b * SEQ + qb * 256) * DM + 1024 + h * 128, SEQ, (char*)lds);
                    __syncthreads();
                }
#endif
                g = pg8::Gemm{pooled, w_pool + (size_t)j * 4 * 65536, MTOK, 1024, 256, 1024, 512}; eo = mixout; eld = DM; ecs = PIN(9) + j * 1024; gk = 4;
            }
        } else if (s == 3) {
            g = pg8::Gemm{mixout, (isab ? w_about : w_cdout) + (size_t)j * DM * DM, MTOK, DM, DM, DM, 0}; ef = y; gk = 1;
        } else if (s == 4) {
            ln_phase(XOUT, xb, PIN(12) + L * DM, PIN(13) + L * DM, (float*)(ws + WS_XCH), false);
        } else if (s == 5) {
            g = pg8::Gemm{xb, w_gu + (size_t)L * 2 * FFH * DM, MTOK, 2 * FFH, DM, DM, 0}; gk = 2;
        } else if (s == 6) {
            g = pg8::Gemm{Hb, w_down + (size_t)L * DM * FFH, MTOK, DM, FFH, FFH, 0}; ef = y2; gk = 3;
        } else {
            ln_phase(XOUT, xb, PIN(17) + L * DM, PIN(18) + L * DM, (float*)(ws + WS_XCH), L == 3);
        }
        if (gk >= 0) {
            pg8::StaticOrder S; S.init(g.M, g.N, lgdim(), lbid());
            PG8_LAS unsigned char* l3 = (PG8_LAS unsigned char*)lds;
            if (gk == 0) { pg8::EpiBf16S E{eo, eld, nullptr, ea0, ea1, ea2}; pg8::gemm_phase<pg8::EpiBf16S, pg8::StaticOrder, true, true, 2048, 2048, 0>(l3, g, S, E); }
            else if (gk == 1) { pg8::EpiF32 E{XOUT, (L == 0) ? PIN(0) : (const float*)XOUT, DM, DN_ALPHA, (L == 0) ? nullptr : (const float*)(ws + WS_XCH), PIN(17) + (L - 1) * DM, PIN(18) + (L - 1) * DM}; pg8::gemm_phase<pg8::EpiF32, pg8::StaticOrder, true, true, 2048, 2048, 0>(l3, g, S, E); }
            else if (gk == 2) { pg8::EpiSwiGLU E{Hb, FFH}; pg8::gemm_phase<pg8::EpiSwiGLU, pg8::StaticOrder, true, true, 2048, 2048, 0>(l3, g, S, E); }
            else if (gk == 3) { pg8::EpiF32 E{XOUT, (const float*)XOUT, DM, DN_ALPHA, (const float*)(ws + WS_XCH), PIN(12) + L * DM, PIN(13) + L * DM}; pg8::gemm_phase<pg8::EpiF32, pg8::StaticOrder, true, true, 5632, 5632, 0>(l3, g, S, E); }
            else { pg8::EpiBf16S E{eo, eld, ecs, 1 << 30, 1 << 30, 1 << 30}; pg8::gemm_phase<pg8::EpiBf16S, pg8::StaticOrder, true, true, 256, 1024, 512>(l3, g, S, E); }
        }
        if (ph + 1 < ph_hi) {
            if (ph == 0) cg::this_grid().sync();
            else { XcdBarrier xb; xb.bar = (unsigned*)(kp->ws + WS_BAR); xb.x = xb_xcc_id(); xb.st = xst; xcd_barrier(xb); } }
    }
}

extern "C" void kernel_launch(void* const* d_in, const int* in_sizes, int n_in, void* d_out, int out_size, void* d_ws, size_t ws_size, hipStream_t stream) {
    static int grid = 0;
    if (grid == 0) {
        if (n_in != 19 || out_size != MTOK * DM || ws_size < WS_TOTAL) { fprintf(stderr, "kernel_launch: unexpected shapes n_in %d out %d ws %zu (need %zu)\n", n_in, out_size, ws_size, (size_t)WS_END); grid = -1; return; }
        int dev = 0, cus = 0, per_cu = 0;
        hipGetDevice(&dev); hipDeviceGetAttribute(&cus, hipDeviceAttributeMultiprocessorCount, dev);
        if (hipFuncSetAttribute((const void*)mega, hipFuncAttributeMaxDynamicSharedMemorySize, LDS_BYTES) != hipSuccess) { fprintf(stderr, "kernel_launch: hipFuncSetAttribute failed\n"); grid = -1; return; }
        if (hipOccupancyMaxActiveBlocksPerMultiprocessor(&per_cu, (const void*)mega, 512, LDS_BYTES) != hipSuccess || per_cu < 1) { fprintf(stderr, "kernel_launch: occupancy query gave %d\n", per_cu); per_cu = 1; }
        (void)hipGetLastError();
        grid = cus * 1;
    }
    if (grid < 0) return;
    Params p{};
    for (int i = 0; i < 19; ++i) p.in[i] = (const float*)d_in[i];
    p.out = (float*)d_out; p.ws = (unsigned char*)d_ws;
#if MK_SINGLE
    if (hipMemsetAsync((char*)d_ws + WS_BAR, 0, XCD_BAR_WORDS * 4, stream) != hipSuccess) { fprintf(stderr, "kernel_launch: memset of the barrier words failed\n"); return; }
    p.ph_lo = 0; p.ph_hi = NPH;
    void* args[] = {&p};
    hipError_t e = hipLaunchCooperativeKernel((const void*)mega, dim3(grid), dim3(512), args, LDS_BYTES, stream);
    if (e != hipSuccess) fprintf(stderr, "cooperative launch failed: %s (grid %d)\n", hipGetErrorString(e), grid);
#else
    for (int ph = 0; ph < NPH; ++ph) {
        if (ph >= 1) { const int L = (ph - 1) >> 3, s = (ph - 1) & 7; if (s == 2 && (L & 1) == 0) continue; }
        p.ph_lo = ph; p.ph_hi = ph + 1;
        hipLaunchKernelGGL(mega, dim3(grid), dim3(512), LDS_BYTES, stream, p);
    }
#endif
}
```
